# Optimizing an MI355X kernel written in HIP

```python
import jax, jax.numpy as jnp
from jax import lax
import numpy as np

D_MODEL = 1024
BATCH = 4
SEQ = 4096
DEPTH = 2

D_MIX = 1024
RWKV_HEAD_DIM = 64
RWKV_HEADS = 6
RWKV_DIM = 384
W_LORA = 32
A_LORA = 32
G_LORA = 64
RWKV_GN_EPS = 64e-5
CONV_DIM = 256
CONV_WIDTH = 31
LN_EPS = 1e-5
MLA_HEADS = 6
QK_NOPE_DIM = 64
QK_ROPE_DIM = 32
V_HEAD_DIM = 64
MLA_DIM = 384
Q_LORA = 256
KV_LORA = 256
ROPE_THETA = 10000.0
Q_BLOCK = 128
D_FF = 4 * D_MODEL
NORM_EPS = 1e-6

P_RWKV = 3 * RWKV_DIM + W_LORA + A_LORA + G_LORA
P_CONV = 2 * CONV_DIM
P_MLA = Q_LORA + KV_LORA + QK_ROPE_DIM
P_IN = P_RWKV + P_CONV + P_MLA

kernel_name = "hybrid_rwkv7_conformer_mla_block"


def rms_norm(x, g):
    xf = x.astype(jnp.float32)
    y = xf * lax.rsqrt(jnp.mean(xf * xf, axis=-1, keepdims=True) + NORM_EPS)
    return (y * g.astype(jnp.float32)).astype(x.dtype)


def layer_norm(x, w, b, eps):
    xf = x.astype(jnp.float32)
    mu = jnp.mean(xf, axis=-1, keepdims=True)
    var = jnp.mean(jnp.square(xf - mu), axis=-1, keepdims=True)
    y = (xf - mu) * lax.rsqrt(var + eps)
    return (y * w.astype(jnp.float32) + b.astype(jnp.float32)).astype(x.dtype)


def rwkv7_step(S, inp):
    r_t, w_t, k_t, v_t, a_t, b_t = inp
    Sa = jnp.einsum('bhvk,bhk->bhv', S, a_t)
    S = S * w_t[:, :, None, :] + Sa[..., None] * b_t[:, :, None, :] + v_t[..., None] * k_t[:, :, None, :]
    y = jnp.einsum('bhvk,bhk->bhv', S, r_t)
    return S, y


def rwkv7_time_mix(p, mu, w0, w2, a0, a2, g2, k_k, k_a, r_k, ln_w, ln_b):
    B, T, _ = p.shape
    H, N = RWKV_HEADS, RWKV_HEAD_DIM
    prev = jnp.pad(p, ((0, 0), (1, 0), (0, 0)))[:, :T]
    z = p + (prev - p) * mu
    cuts = [RWKV_DIM, 2 * RWKV_DIM, 3 * RWKV_DIM, 3 * RWKV_DIM + W_LORA, 3 * RWKV_DIM + W_LORA + A_LORA]
    r, k, v, w_lo, a_lo, g_lo = jnp.split(z, cuts, axis=-1)
    w = -jax.nn.softplus(-(w0 + jnp.tanh(w_lo) @ w2)) - 0.5
    a = jax.nn.sigmoid(a0 + a_lo @ a2)
    g = jax.nn.sigmoid(g_lo) @ g2
    kk = (k * k_k).reshape(B, T, H, N).astype(jnp.float32)
    kk = kk * lax.rsqrt(jnp.maximum(jnp.sum(kk * kk, axis=-1, keepdims=True), 1e-24))
    k = k * (1 + (a - 1) * k_a)

    def heads(t):
        return t.reshape(B, T, H, N).astype(jnp.float32)

    r_h, k_h, v_h, a_h = heads(r), heads(k), heads(v), heads(a)
    decay = jnp.exp(-jnp.exp(heads(w)))

    def tmaj(t):
        return jnp.moveaxis(t, 1, 0)

    xs = (tmaj(r_h), tmaj(decay), tmaj(k_h), tmaj(v_h), tmaj(-kk), tmaj(kk * a_h))
    S0 = jnp.zeros((B, H, N, N), jnp.float32)
    _, y = lax.scan(rwkv7_step, S0, xs)
    y = jnp.moveaxis(y, 0, 1)
    m = jnp.mean(y, axis=-1, keepdims=True)
    var = jnp.mean(jnp.square(y - m), axis=-1, keepdims=True)
    y = ((y - m) * lax.rsqrt(var + RWKV_GN_EPS)).reshape(B, T, RWKV_DIM)
    y = y * ln_w.astype(jnp.float32) + ln_b.astype(jnp.float32)
    bonus = jnp.sum(r_h * k_h * r_k.astype(jnp.float32), axis=-1, keepdims=True) * v_h
    y = y + bonus.reshape(B, T, RWKV_DIM)
    return y.astype(p.dtype) * g


def conformer_conv(p, conv_w, conv_b, ln_w, ln_b):
    u, gt = jnp.split(p, 2, axis=-1)
    h = u * jax.nn.sigmoid(gt)
    h = lax.conv_general_dilated(
        h, conv_w[:, None, :], window_strides=(1,), padding=((CONV_WIDTH - 1, 0),),
        dimension_numbers=('NWC', 'WIO', 'NWC'), feature_group_count=CONV_DIM) + conv_b
    h = layer_norm(h, ln_w, ln_b, LN_EPS)
    return jax.nn.silu(h)


def rope_cos_sin(positions):
    inv_freq = 1.0 / (ROPE_THETA ** (jnp.arange(0, QK_ROPE_DIM, 2, dtype=jnp.float32) / QK_ROPE_DIM))
    ang = positions.astype(jnp.float32)[..., None] * inv_freq
    ang = jnp.concatenate([ang, ang], axis=-1)
    return jnp.cos(ang), jnp.sin(ang)


def apply_rope(x, cos, sin):
    xf = x.astype(jnp.float32)
    x1, x2 = jnp.split(xf, 2, axis=-1)
    rot = jnp.concatenate([-x2, x1], axis=-1)
    return (xf * cos + rot * sin).astype(x.dtype)


def mla_attention(p, positions, q_norm, w_uq, kv_norm, w_ukv):
    B, T, _ = p.shape
    H = MLA_HEADS
    q_c, c_kv, k_pe = jnp.split(p, [Q_LORA, Q_LORA + KV_LORA], axis=-1)
    q = (rms_norm(q_c, q_norm) @ w_uq).reshape(B, T, H, QK_NOPE_DIM + QK_ROPE_DIM)
    q_nope, q_pe = q[..., :QK_NOPE_DIM], q[..., QK_NOPE_DIM:]
    kv = (rms_norm(c_kv, kv_norm) @ w_ukv).reshape(B, T, H, QK_NOPE_DIM + V_HEAD_DIM)
    k_nope, v = kv[..., :QK_NOPE_DIM], kv[..., QK_NOPE_DIM:]
    cos, sin = rope_cos_sin(positions)
    q_pe = apply_rope(q_pe, cos[:, :, None, :], sin[:, :, None, :])
    k_pe = apply_rope(k_pe, cos, sin)
    q = jnp.concatenate([q_nope, q_pe], axis=-1).transpose(0, 2, 1, 3)
    k = jnp.concatenate([k_nope, jnp.broadcast_to(k_pe[:, :, None, :], (B, T, H, QK_ROPE_DIM))],
                        axis=-1).transpose(0, 2, 1, 3)
    v = v.transpose(0, 2, 1, 3)
    scale = (QK_NOPE_DIM + QK_ROPE_DIM) ** -0.5
    outs = []
    for i in range(T // Q_BLOCK):
        qs, ke = i * Q_BLOCK, (i + 1) * Q_BLOCK
        s = jnp.einsum('bhqd,bhkd->bhqk', q[:, :, qs:ke], k[:, :, :ke]).astype(jnp.float32) * scale
        mask = (qs + jnp.arange(Q_BLOCK))[:, None] >= jnp.arange(ke)[None, :]
        s = jnp.where(mask, s, -jnp.inf)
        pr = jax.nn.softmax(s, axis=-1).astype(v.dtype)
        outs.append(jnp.einsum('bhqk,bhkd->bhqd', pr, v[:, :, :ke]))
    o = jnp.concatenate(outs, axis=2)
    return o.transpose(0, 2, 1, 3).reshape(B, T, MLA_DIM)


def setup_inputs(seed: int = 0) -> dict:
    key = jax.random.key(seed)
    keys = iter(jax.random.split(key, 40))
    L, D = DEPTH, D_MODEL
    f32 = jnp.float32

    def normal(shape, scale):
        return scale * jax.random.normal(next(keys), shape, f32)

    def gain(shape):
        return 1.0 + normal(shape, 0.05)

    def uniform(shape, lo, hi):
        return jax.random.uniform(next(keys), shape, f32, lo, hi)

    x = normal((BATCH, SEQ, D), 1.0)
    c = normal((BATCH, D), 1.0)
    offset = jax.random.randint(next(keys), (BATCH, 1), 0, 1024, dtype=jnp.int32)
    positions = offset + jnp.arange(SEQ, dtype=jnp.int32)[None, :]
    return {
        "x": x,
        "c": c,
        "positions": positions,
        "g_pre_mix": gain((L, D)),
        "g_post_mix": gain((L, D)),
        "g_pre_ffn": gain((L, D)),
        "g_post_ffn": gain((L, D)),
        "w_ada": normal((L, D, 6 * D), 0.5 * D ** -0.5),
        "b_ada": normal((L, 6 * D), 0.02),
        "w_in": normal((L, D, P_IN), D ** -0.5),
        "w_out": normal((L, D_MIX, D), D_MIX ** -0.5),
        "rwkv_mu": uniform((L, P_RWKV), 0.0, 1.0),
        "rwkv_w0": uniform((L, RWKV_DIM), -6.0, -1.0),
        "rwkv_w2": normal((L, W_LORA, RWKV_DIM), W_LORA ** -0.5),
        "rwkv_a0": normal((L, RWKV_DIM), 0.5),
        "rwkv_a2": normal((L, A_LORA, RWKV_DIM), A_LORA ** -0.5),
        "rwkv_g2": normal((L, G_LORA, RWKV_DIM), G_LORA ** -0.5),
        "rwkv_k_k": 0.85 + normal((L, RWKV_DIM), 0.05),
        "rwkv_k_a": gain((L, RWKV_DIM)),
        "rwkv_r_k": normal((L, RWKV_HEADS, RWKV_HEAD_DIM), 0.1),
        "rwkv_ln_w": gain((L, RWKV_DIM)),
        "rwkv_ln_b": normal((L, RWKV_DIM), 0.02),
        "conv_w": normal((L, CONV_WIDTH, CONV_DIM), CONV_WIDTH ** -0.5),
        "conv_b": normal((L, CONV_DIM), 0.02),
        "conv_ln_w": gain((L, CONV_DIM)),
        "conv_ln_b": normal((L, CONV_DIM), 0.02),
        "mla_q_norm": gain((L, Q_LORA)),
        "mla_w_uq": normal((L, Q_LORA, MLA_HEADS * (QK_NOPE_DIM + QK_ROPE_DIM)), Q_LORA ** -0.5),
        "mla_kv_norm": gain((L, KV_LORA)),
        "mla_w_ukv": normal((L, KV_LORA, MLA_HEADS * (QK_NOPE_DIM + V_HEAD_DIM)), KV_LORA ** -0.5),
        "w_ff1": normal((L, D, D_FF), D ** -0.5),
        "w_ff2": normal((L, D_FF, D), D_FF ** -0.5),
    }


def reference(x, c, positions, g_pre_mix, g_post_mix, g_pre_ffn, g_post_ffn, w_ada, b_ada,
              w_in, w_out, rwkv_mu, rwkv_w0, rwkv_w2, rwkv_a0, rwkv_a2, rwkv_g2, rwkv_k_k,
              rwkv_k_a, rwkv_r_k, rwkv_ln_w, rwkv_ln_b, conv_w, conv_b, conv_ln_w, conv_ln_b,
              mla_q_norm, mla_w_uq, mla_kv_norm, mla_w_ukv, w_ff1, w_ff2):
    cs = jax.nn.silu(c)
    for l in range(DEPTH):
        mod = (cs @ w_ada[l] + b_ada[l])[:, None, :]
        sh1, sc1, gt1, sh2, sc2, gt2 = jnp.split(mod, 6, axis=-1)

        h = rms_norm(x, g_pre_mix[l]) * (1 + sc1) + sh1
        p = h @ w_in[l]
        p_rwkv, p_conv, p_mla = jnp.split(p, [P_RWKV, P_RWKV + P_CONV], axis=-1)
        y_a = rwkv7_time_mix(p_rwkv, rwkv_mu[l], rwkv_w0[l], rwkv_w2[l], rwkv_a0[l], rwkv_a2[l],
                             rwkv_g2[l], rwkv_k_k[l], rwkv_k_a[l], rwkv_r_k[l], rwkv_ln_w[l], rwkv_ln_b[l])
        y_b = conformer_conv(p_conv, conv_w[l], conv_b[l], conv_ln_w[l], conv_ln_b[l])
        y_c = mla_attention(p_mla, positions, mla_q_norm[l], mla_w_uq[l], mla_kv_norm[l], mla_w_ukv[l])
        y = jnp.concatenate([y_a, y_b, y_c], axis=-1) @ w_out[l]
        x = x + gt1 * rms_norm(y, g_post_mix[l])

        h = rms_norm(x, g_pre_ffn[l]) * (1 + sc2) + sh2
        y = jnp.square(jax.nn.relu(h @ w_ff1[l])) @ w_ff2[l]
        x = x + gt2 * rms_norm(y, g_post_ffn[l])
    return x
```

```cpp
#include <hip/hip_runtime.h>
#include <hip/hip_cooperative_groups.h>
#include <cstdio>
namespace cg = cooperative_groups;

#ifndef SINGLE_LAUNCH
#define SINGLE_LAUNCH 1
#endif

#ifndef PROBE_SPLIT
#define PROBE_SPLIT 0
#endif
#ifndef PROBE_PREP
#define PROBE_PREP 0
#endif
#ifndef PROBE_REP
#define PROBE_REP 0
#endif
#define DI __device__ __forceinline__
typedef unsigned short bf16_t;
using bf16x8 = __attribute__((ext_vector_type(8))) short;
using f32x4 = __attribute__((ext_vector_type(4))) float;
using f32x2 = __attribute__((ext_vector_type(2))) float;

constexpr int T_SEQ = 4096;
constexpr int NPHASE = 20;

constexpr size_t OFF_WIN = 0;
constexpr size_t OFF_WOUT = OFF_WIN + 2432ull * 1024 * 2;
constexpr size_t OFF_WFF1 = OFF_WOUT + 1024ull * 1024 * 2;
constexpr size_t OFF_WFF2 = OFF_WFF1 + 4096ull * 1024 * 2;
constexpr size_t OFF_WUQ = OFF_WFF2 + 4096ull * 1024 * 2;
constexpr size_t OFF_WUKV = OFF_WUQ + 640ull * 256 * 2;
constexpr size_t OFF_MISC = OFF_WUKV + 768ull * 256 * 2;
constexpr size_t OFF_MOD = OFF_MISC;
constexpr size_t OFF_BONUS = OFF_MISC + 262144;
constexpr size_t OFF_LORA = OFF_MISC + 655360;
constexpr size_t OFF_CNT = OFF_MISC + 786432;
constexpr size_t OFF_BAR = OFF_MISC + 786432 + 4096;
constexpr size_t OFF_H = OFF_MISC + 1048576;
constexpr size_t OFF_ARENA = OFF_H + 16384ull * 1024 * 2;
constexpr size_t OFF_Y = OFF_ARENA;
constexpr size_t OFF_HID = OFF_ARENA + 67108864ull;
constexpr size_t OFF_SI = OFF_ARENA;
constexpr size_t OFF_P = OFF_SI + 16384ull * 6 * 768;
constexpr size_t OFF_Q = OFF_P + 16384ull * 2336 * 2;
constexpr size_t OFF_KN = OFF_Q + 16384ull * 576 * 2;
constexpr size_t OFF_VT = OFF_KN + 16384ull * 384 * 2;
constexpr size_t OFF_KPE = OFF_VT + 16384ull * 384 * 2;
constexpr size_t OFF_YRAW = OFF_P;
static_assert(OFF_KPE + 16384ull * 32 * 2 <= 268435456ull, "ws");
static_assert(OFF_HID + 16384ull * 4096 * 2 <= 268435456ull, "ws");

struct Params {
  const float* x; const float* c; const int* pos;
  const float *g_pre_mix, *g_post_mix, *g_pre_ffn, *g_post_ffn, *w_ada, *b_ada, *w_in, *w_out;
  const float *mu, *w0, *w2, *a0, *a2, *g2, *k_k, *k_a, *r_k, *rln_w, *rln_b;
  const float *conv_w, *conv_b, *cln_w, *cln_b;
  const float *q_norm, *w_uq, *kv_norm, *w_ukv, *w_ff1, *w_ff2;
  float* out;
  char* ws;
};

DI bf16_t f2bf(float x) { unsigned u = __float_as_uint(x); u += 0x7fffu + ((u >> 16) & 1u); return (bf16_t)(u >> 16); }
DI float bf2f(bf16_t h) { return __uint_as_float(((unsigned)h) << 16); }
DI unsigned pack2(float a, float b) { return (unsigned)f2bf(a) | ((unsigned)f2bf(b) << 16); }
DI float bflo(unsigned u) { return __uint_as_float(u << 16); }
DI float bfhi(unsigned u) { return __uint_as_float(u & 0xffff0000u); }

DI void fmac(float& acc, float a, float b) { asm("v_fmac_f32 %0, %1, %2" : "+v"(acc) : "v"(a), "v"(b)); }
DI float sigmoidf_(float x) { return __builtin_amdgcn_rcpf(1.f + __expf(-x)); }
template <int CTRL> DI float dppf(float x) {
  return __int_as_float(__builtin_amdgcn_update_dpp(0, __float_as_int(x), CTRL, 0xf, 0xf, true));
}
DI float allreduce16(float x) {
  x += dppf<0xB1>(x);
  x += dppf<0x4E>(x);
  x += dppf<0x141>(x);
  x += dppf<0x140>(x);
  return x;
}
DI float wave_sum(float v) {
  v = allreduce16(v);
  const int iv = __float_as_int(v);
  float s0 = __int_as_float(__builtin_amdgcn_readlane(iv, 0)), s1 = __int_as_float(__builtin_amdgcn_readlane(iv, 16));
  float s2 = __int_as_float(__builtin_amdgcn_readlane(iv, 32)), s3 = __int_as_float(__builtin_amdgcn_readlane(iv, 48));
  return (s0 + s1) + (s2 + s3);
}


#define XB_TMO      128
#define XB_XCNT(j)  (256  + 64 * (j))
#define XB_XSUB(j)  (1280 + 64 * (j))
#define XB_XGEN(j)  (2304 + 64 * (j))
#define XB_TOP      3328
#define XB_TOPGEN   3392
#define XCD_BAR_WORDS 3456
#define XB_SPIN_CAP (1u << 18)
#define LAS __attribute__((address_space(3)))
DI unsigned xb_ld(unsigned* p) { return __hip_atomic_load(p, __ATOMIC_RELAXED, __HIP_MEMORY_SCOPE_AGENT); }
DI unsigned xb_add(unsigned* p, unsigned v) { return __hip_atomic_fetch_add(p, v, __ATOMIC_RELAXED, __HIP_MEMORY_SCOPE_AGENT); }
DI unsigned xb_xcc_id() { return (unsigned)__builtin_amdgcn_s_getreg((3 << 11) | 20) & 0xFu; }
#define XB_SPIN(cond, bar) do { unsigned _sp = 0; while (cond) { __builtin_amdgcn_s_sleep(1); \
    if ((++_sp & 255u) == 0u) { if (xb_ld(&(bar)[XB_TMO])) break; if (_sp > XB_SPIN_CAP) { atomicAdd(&(bar)[XB_TMO], 1u); break; } } } } while (0)
struct XcdBarrier { unsigned* bar; unsigned x; volatile LAS unsigned* st; };
DI XcdBarrier xcd_barrier_post(unsigned* bar, volatile LAS unsigned* st) {
  XcdBarrier b; b.bar = bar; b.x = xb_xcc_id(); b.st = st;
  if (threadIdx.x == 0) (void)xb_add(&bar[XB_XCNT(b.x)], 1u);
  return b;
}
DI void xcd_barrier_complete(unsigned* bar, unsigned x, unsigned& nloc, unsigned& nx) {
  const unsigned G = gridDim.x * gridDim.y * gridDim.z;
  unsigned sum, cnt, mine, sp = 0u;
  for (;;) {
    sum = 0u; cnt = 0u; mine = 0u;
#pragma unroll
    for (unsigned j = 0; j < 16; ++j) { const unsigned c = xb_ld(&bar[XB_XCNT(j)]); sum += c; cnt += (c > 0u) ? 1u : 0u; mine = (j == x) ? c : mine; }
    if (sum == G) break;
    __builtin_amdgcn_s_sleep(1);
    if ((++sp & 255u) == 0u) { if (xb_ld(&bar[XB_TMO])) break; if (sp > XB_SPIN_CAP) { atomicAdd(&bar[XB_TMO], 1u); break; } }
  }
  nloc = mine > 0u ? mine : 1u; nx = cnt > 0u ? cnt : 1u;
}
DI void xcd_barrier(const XcdBarrier& b) {
  asm volatile("s_waitcnt vmcnt(0)" ::: "memory");
  __syncthreads();
  if (threadIdx.x == 0) {
    unsigned* bar = b.bar;
    __builtin_amdgcn_s_waitcnt(0);
    unsigned nloc = b.st[0], nx = b.st[1];
    if (nloc == 0u) { xcd_barrier_complete(bar, b.x, nloc, nx); b.st[0] = nloc; b.st[1] = nx; }
    const unsigned old = xb_add(&bar[XB_XSUB(b.x)], 1u);
    const unsigned gen = old / nloc;
    if (old + 1u == (gen + 1u) * nloc) {
      __builtin_amdgcn_fence(__ATOMIC_RELEASE, "agent");
      asm volatile("s_waitcnt vmcnt(0)" ::: "memory");
      const unsigned og = xb_add(&bar[XB_TOP], 1u);
      const unsigned tg = og / nx;
      if (og + 1u == (tg + 1u) * nx) xb_add(&bar[XB_TOPGEN], 1u);
      else XB_SPIN(xb_ld(&bar[XB_TOPGEN]) == tg, bar);
      __builtin_amdgcn_fence(__ATOMIC_ACQUIRE, "agent");
      xb_add(&bar[XB_XGEN(b.x)], 1u);
      asm volatile("s_waitcnt vmcnt(0)" ::: "memory");
    } else {
      XB_SPIN(xb_ld(&bar[XB_XGEN(b.x)]) == gen, bar);
      __builtin_amdgcn_fence(__ATOMIC_ACQUIRE, "agent");
      asm volatile("s_waitcnt vmcnt(0)" ::: "memory");
    }
  }
  __syncthreads();
}

DI void sub_barrier_wait(unsigned* ctr, unsigned n) {
  if (threadIdx.x == 0) {
    unsigned sp = 0;
    while (xb_ld(ctr) < n) { __builtin_amdgcn_s_sleep(2); if (++sp > (1u << 22)) break; }
    __builtin_amdgcn_fence(__ATOMIC_ACQUIRE, "agent");
    asm volatile("s_waitcnt vmcnt(0)" ::: "memory");
  }
  __syncthreads();
}
DI void sub_barrier(unsigned* ctr, unsigned n) {
  asm volatile("s_waitcnt vmcnt(0)" ::: "memory");
  __syncthreads();
  if (threadIdx.x == 0) {
    __builtin_amdgcn_fence(__ATOMIC_RELEASE, "agent");
    asm volatile("s_waitcnt vmcnt(0)" ::: "memory");
    (void)xb_add(ctr, 1u);
  }
  sub_barrier_wait(ctr, n);
}

DI void convert_tile(const float* __restrict__ W, int Kdim, int Ndim, bf16_t* __restrict__ Wt, int kt, int nt,
                     const float* __restrict__ kscale, char* smem) {
  float (*s)[65] = (float (*)[65])smem;
  const int tid = threadIdx.x;
#pragma unroll
  for (int i = 0; i < 16; ++i) {
    int idx = tid + 256 * i; int kk = idx >> 6, nn = idx & 63;
    int n = nt * 64 + nn, k = kt * 64 + kk;
    float v = (n < Ndim) ? W[(size_t)k * Ndim + n] : 0.f;
    if (kscale) v *= kscale[k];
    s[kk][nn] = v;
  }
  __syncthreads();
#pragma unroll 4
  for (int i = 0; i < 8; ++i) {
    int idx = tid + 256 * i; int nn = idx >> 5, kp = idx & 31;
    unsigned pk = pack2(s[2 * kp][nn], s[2 * kp + 1][nn]);
    *(unsigned*)(Wt + (size_t)(nt * 64 + nn) * Kdim + kt * 64 + 2 * kp) = pk;
  }
  __syncthreads();
}

DI void convert_layer(const Params& P, int l, char* smem) {
  char* ws = P.ws;
  const int n_in = 16 * 38, n_out = 16 * 16, n_ff1 = 16 * 64, n_ff2 = 64 * 16, n_uq = 4 * 10, n_ukv = 4 * 12;
  const int total = n_in + n_out + n_ff1 + n_ff2 + n_uq + n_ukv;
  for (int it = blockIdx.x; it < 6; it += gridDim.x) {
    bf16_t* lo = (bf16_t*)(ws + OFF_LORA) + it * 8192;
    for (int i = 0; i < 32; ++i) {
      int e = threadIdx.x + 256 * i; int n = e >> 7, k = e & 127; int cg_ = it * 64 + n;
      float v = (k < 32) ? P.w2[((size_t)l * 32 + k) * 384 + cg_] : (k < 64) ? P.a2[((size_t)l * 32 + (k - 32)) * 384 + cg_] : P.g2[((size_t)l * 64 + (k - 64)) * 384 + cg_];
      lo[e] = f2bf(v);
    }
  }
  for (int it = blockIdx.x; it < total; it += gridDim.x) {
    int i = it;
    if (i < n_in) { convert_tile(P.w_in + (size_t)l * 1024 * 2336, 1024, 2336, (bf16_t*)(ws + OFF_WIN), i % 16, i / 16, nullptr, smem); continue; }
    i -= n_in;
    if (i < n_out) { convert_tile(P.w_out + (size_t)l * 1024 * 1024, 1024, 1024, (bf16_t*)(ws + OFF_WOUT), i % 16, i / 16, nullptr, smem); continue; }
    i -= n_out;
    if (i < n_ff1) { convert_tile(P.w_ff1 + (size_t)l * 1024 * 4096, 1024, 4096, (bf16_t*)(ws + OFF_WFF1), i % 16, i / 16, nullptr, smem); continue; }
    i -= n_ff1;
    if (i < n_ff2) { convert_tile(P.w_ff2 + (size_t)l * 4096 * 1024, 4096, 1024, (bf16_t*)(ws + OFF_WFF2), i % 64, i / 64, nullptr, smem); continue; }
    i -= n_ff2;
    if (i < n_uq) { convert_tile(P.w_uq + (size_t)l * 256 * 576, 256, 576, (bf16_t*)(ws + OFF_WUQ), i % 4, i / 4, P.q_norm + l * 256, smem); continue; }
    i -= n_uq;
    convert_tile(P.w_ukv + (size_t)l * 256 * 768, 256, 768, (bf16_t*)(ws + OFF_WUKV), i % 4, i / 4, P.kv_norm + l * 256, smem);
  }
}

DI void mod_items(const Params& P, char* smem) {
  float* cs = (float*)smem;
  float* red = cs + 4096;
  float* mod = (float*)(P.ws + OFF_MOD);
  const int tid = threadIdx.x;
  for (int it = blockIdx.x; it < 192; it += gridDim.x) {
    int l = it / 96, nc = it % 96;
    __syncthreads();
    for (int i = 0; i < 16; ++i) { int idx = tid + 256 * i; float v = P.c[idx]; cs[idx] = v * sigmoidf_(v); }
    __syncthreads();
    int kg = tid >> 6, cn = tid & 63, n = nc * 64 + cn;
    const float* wp = P.w_ada + (size_t)l * 1024 * 6144 + n;
    float a0 = 0, a1 = 0, a2 = 0, a3 = 0;
#pragma unroll 16
    for (int k = kg * 256; k < kg * 256 + 256; ++k) {
      float w = wp[(size_t)k * 6144];
      a0 += cs[k] * w; a1 += cs[1024 + k] * w; a2 += cs[2048 + k] * w; a3 += cs[3072 + k] * w;
    }
    red[(kg * 4 + 0) * 64 + cn] = a0; red[(kg * 4 + 1) * 64 + cn] = a1; red[(kg * 4 + 2) * 64 + cn] = a2; red[(kg * 4 + 3) * 64 + cn] = a3;
    __syncthreads();
    {
      int b = tid >> 6;
      float s = red[(0 * 4 + b) * 64 + cn] + red[(1 * 4 + b) * 64 + cn] + red[(2 * 4 + b) * 64 + cn] + red[(3 * 4 + b) * 64 + cn];
      mod[(size_t)(l * 4 + b) * 6144 + n] = s + P.b_ada[l * 6144 + n];
    }
  }
}

DI void row_pass(const float* xsrc, const bf16_t* __restrict__ y, const float* __restrict__ gate,
                 const float* __restrict__ g_post, float* xdst, const float* __restrict__ g_pre,
                 const float* __restrict__ sc, const float* __restrict__ sh, bf16_t* __restrict__ hdst) {
  const int lane = threadIdx.x & 63, w = threadIdx.x >> 6;
  for (int row0 = (blockIdx.x * 4 + w) * 2; row0 < 16384; row0 += gridDim.x * 8) {
    const int b = row0 >> 12;
    float4 xv[2][4], yv[2][4];
#pragma unroll
    for (int r = 0; r < 2; ++r)
#pragma unroll
      for (int i = 0; i < 4; ++i) {
        xv[r][i] = *(const float4*)(xsrc + (size_t)(row0 + r) * 1024 + lane * 4 + 256 * i);
        if (y) {
          const uint2 yb = *(const uint2*)(y + (size_t)(row0 + r) * 1024 + lane * 4 + 256 * i);
          yv[r][i] = float4{bflo(yb.x), bfhi(yb.x), bflo(yb.y), bfhi(yb.y)};
        }
      }
    if (y) {
      float ss[2];
#pragma unroll
      for (int r = 0; r < 2; ++r) {
        float s = 0;
#pragma unroll
        for (int i = 0; i < 4; ++i) s += yv[r][i].x * yv[r][i].x + yv[r][i].y * yv[r][i].y + yv[r][i].z * yv[r][i].z + yv[r][i].w * yv[r][i].w;
        ss[r] = s;
      }
      ss[0] = wave_sum(ss[0]); ss[1] = wave_sum(ss[1]);
#pragma unroll
      for (int i = 0; i < 4; ++i) {
        int col = lane * 4 + 256 * i;
        float4 g = *(const float4*)(g_post + col);
        float4 gt = *(const float4*)(gate + (size_t)b * 6144 + col);
#pragma unroll
        for (int r = 0; r < 2; ++r) {
          float rstd = rsqrtf(ss[r] * (1.f / 1024.f) + 1e-6f);
          xv[r][i].x += gt.x * (yv[r][i].x * rstd * g.x); xv[r][i].y += gt.y * (yv[r][i].y * rstd * g.y);
          xv[r][i].z += gt.z * (yv[r][i].z * rstd * g.z); xv[r][i].w += gt.w * (yv[r][i].w * rstd * g.w);
        }
      }
    }
    if (xdst) {
#pragma unroll
      for (int r = 0; r < 2; ++r)
#pragma unroll
        for (int i = 0; i < 4; ++i) *(float4*)(xdst + (size_t)(row0 + r) * 1024 + lane * 4 + 256 * i) = xv[r][i];
    }
    if (hdst) {
      float ss[2];
#pragma unroll
      for (int r = 0; r < 2; ++r) {
        float s = 0;
#pragma unroll
        for (int i = 0; i < 4; ++i) s += xv[r][i].x * xv[r][i].x + xv[r][i].y * xv[r][i].y + xv[r][i].z * xv[r][i].z + xv[r][i].w * xv[r][i].w;
        ss[r] = s;
      }
      ss[0] = wave_sum(ss[0]); ss[1] = wave_sum(ss[1]);
#pragma unroll
      for (int i = 0; i < 4; ++i) {
        int col = lane * 4 + 256 * i;
        float4 g = *(const float4*)(g_pre + col);
        float4 s1 = *(const float4*)(sc + (size_t)b * 6144 + col);
        float4 s0 = *(const float4*)(sh + (size_t)b * 6144 + col);
#pragma unroll
        for (int r = 0; r < 2; ++r) {
          float rstd = rsqrtf(ss[r] * (1.f / 1024.f) + 1e-6f);
          float h0 = xv[r][i].x * rstd * g.x * (1.f + s1.x) + s0.x;
          float h1 = xv[r][i].y * rstd * g.y * (1.f + s1.y) + s0.y;
          float h2 = xv[r][i].z * rstd * g.z * (1.f + s1.z) + s0.z;
          float h3 = xv[r][i].w * rstd * g.w * (1.f + s1.w) + s0.w;
          uint2 o; o.x = pack2(h0, h1); o.y = pack2(h2, h3);
          *(uint2*)(hdst + (size_t)(row0 + r) * 1024 + col) = o;
        }
      }
    }
  }
}

enum { EPI_P = 0, EPI_Q = 1, EPI_KV = 2, EPI_Y = 3, EPI_FF1 = 4 };

template <int EPI>
DI void gemm_tile(const bf16_t* __restrict__ A, int lda, const bf16_t* __restrict__ Bt, int K, int m0, int n0,
                  char* smem, void* out0, void* out1) {
  bf16_t* As = (bf16_t*)smem;
  bf16_t* Bs = As + 2 * 128 * 64;
  float* rs = (float*)(smem + 73728);
  const int tid = threadIdx.x, lane = tid & 63, w = tid >> 6, wm = w >> 1, wn = w & 1, qi = lane & 15, quad = lane >> 4;
  __syncthreads();
  if (EPI == EPI_Q || EPI == EPI_KV) {
    int row = tid >> 1, half = tid & 1;
    const uint4* src = (const uint4*)(A + (size_t)(m0 + row) * lda + half * 128);
    float ss = 0;
#pragma unroll
    for (int i = 0; i < 16; ++i) {
      uint4 v = src[i];
      float f;
      f = bflo(v.x); ss += f * f; f = bfhi(v.x); ss += f * f;
      f = bflo(v.y); ss += f * f; f = bfhi(v.y); ss += f * f;
      f = bflo(v.z); ss += f * f; f = bfhi(v.z); ss += f * f;
      f = bflo(v.w); ss += f * f; f = bfhi(v.w); ss += f * f;
    }
    ss += __shfl_xor(ss, 1);
    if (half == 0) rs[row] = rsqrtf(ss * (1.f / 256.f) + 1e-6f);
  }
  f32x4 acc[4][4];
#pragma unroll
  for (int i = 0; i < 4; ++i)
#pragma unroll
    for (int j = 0; j < 4; ++j) acc[i][j] = f32x4{0.f, 0.f, 0.f, 0.f};
  uint4 p0, p1, p2, p3, p4, p5, p6, p7;
  uint4 q0, q1, q2, q3, q4, q5, q6, q7;
  const int KT = K >> 6;
  const int lrow = tid >> 3, lcc = tid & 7;
  const bf16_t* Ap = A + (size_t)(m0 + lrow) * lda + lcc * 8;
  const bf16_t* Bp = Bt + (size_t)(n0 + lrow) * K + lcc * 8;
  const int wpos = (lcc ^ ((lrow >> 1) & 7)) * 8;
  bf16_t* Aw = As + lrow * 64 + wpos;
  bf16_t* Bw = Bs + lrow * 64 + wpos;
  const int rp0 = (quad ^ ((qi >> 1) & 7)) * 8, rp1 = rp0 ^ 32;
#define GLOAD(kt, R0, R1, R2, R3, R4, R5, R6, R7)                        \
  {                                                                      \
    R0 = *(const uint4*)(Ap + (size_t)(0) * lda + (kt) * 64);            \
    R1 = *(const uint4*)(Ap + (size_t)(32) * lda + (kt) * 64);           \
    R2 = *(const uint4*)(Ap + (size_t)(64) * lda + (kt) * 64);           \
    R3 = *(const uint4*)(Ap + (size_t)(96) * lda + (kt) * 64);           \
    R4 = *(const uint4*)(Bp + (size_t)(0) * K + (kt) * 64);              \
    R5 = *(const uint4*)(Bp + (size_t)(32) * K + (kt) * 64);             \
    R6 = *(const uint4*)(Bp + (size_t)(64) * K + (kt) * 64);             \
    R7 = *(const uint4*)(Bp + (size_t)(96) * K + (kt) * 64);             \
  }
#define SWRITE(buf, R0, R1, R2, R3, R4, R5, R6, R7)                      \
  {                                                                      \
    *(uint4*)(Aw + ((buf) * 128 + 0) * 64) = R0;                         \
    *(uint4*)(Aw + ((buf) * 128 + 32) * 64) = R1;                        \
    *(uint4*)(Aw + ((buf) * 128 + 64) * 64) = R2;                        \
    *(uint4*)(Aw + ((buf) * 128 + 96) * 64) = R3;                        \
    *(uint4*)(Bw + ((buf) * 128 + 0) * 64) = R4;                         \
    *(uint4*)(Bw + ((buf) * 128 + 32) * 64) = R5;                        \
    *(uint4*)(Bw + ((buf) * 128 + 64) * 64) = R6;                        \
    *(uint4*)(Bw + ((buf) * 128 + 96) * 64) = R7;                        \
  }
#define GLOAD0(kt) GLOAD(kt, p0, p1, p2, p3, p4, p5, p6, p7)
#define GLOAD1(kt) GLOAD(kt, q0, q1, q2, q3, q4, q5, q6, q7)
#define SWRITE0(buf) SWRITE(buf, p0, p1, p2, p3, p4, p5, p6, p7)
#define SWRITE1(buf) SWRITE(buf, q0, q1, q2, q3, q4, q5, q6, q7)
#define LBAR { asm volatile("s_waitcnt lgkmcnt(0)" ::: "memory"); __builtin_amdgcn_s_barrier(); }
#define FRAGS(buf)                                                                                        \
  {                                                                                                       \
    const bf16_t* as = As + (buf) * 128 * 64 + (wm * 64 + qi) * 64;                                       \
    const bf16_t* bs = Bs + (buf) * 128 * 64 + (wn * 64 + qi) * 64;                                       \
    _Pragma("unroll") for (int i = 0; i < 4; ++i) {                                                       \
      af0[i] = *(const bf16x8*)(as + i * 16 * 64 + rp0);                                                  \
      bf0[i] = *(const bf16x8*)(bs + i * 16 * 64 + rp0);                                                  \
    }                                                                                                     \
    _Pragma("unroll") for (int i = 0; i < 4; ++i) af1[i] = *(const bf16x8*)(as + i * 16 * 64 + rp1);      \
    bf1[0] = *(const bf16x8*)(bs + 0 * 16 * 64 + rp1);                                                    \
    bf1[1] = *(const bf16x8*)(bs + 1 * 16 * 64 + rp1);                                                    \
  }
#define MMA(buf, SWR)                                                                                     \
  {                                                                                                       \
    __builtin_amdgcn_s_setprio(1);                                                                        \
    _Pragma("unroll") for (int mt = 0; mt < 4; ++mt)                                                      \
      _Pragma("unroll") for (int nt = 0; nt < 4; ++nt)                                                    \
        acc[mt][nt] = __builtin_amdgcn_mfma_f32_16x16x32_bf16(bf0[nt], af0[mt], acc[mt][nt], 0, 0, 0);    \
    __builtin_amdgcn_sched_barrier(0);                                                                    \
    SWR;                                                                                                  \
    {                                                                                                     \
      const bf16_t* bs = Bs + (buf) * 128 * 64 + (wn * 64 + qi) * 64;                                     \
      bf1[2] = *(const bf16x8*)(bs + 2 * 16 * 64 + rp1);                                                  \
      bf1[3] = *(const bf16x8*)(bs + 3 * 16 * 64 + rp1);                                                  \
    }                                                                                                     \
    _Pragma("unroll") for (int nt = 0; nt < 4; ++nt)                                                      \
      _Pragma("unroll") for (int mt = 0; mt < 4; ++mt)                                                    \
        acc[mt][nt] = __builtin_amdgcn_mfma_f32_16x16x32_bf16(bf1[nt], af1[mt], acc[mt][nt], 0, 0, 0);    \
    __builtin_amdgcn_s_setprio(0);                                                                        \
  }
  bf16x8 af0[4], bf0[4], af1[4], bf1[4];
  GLOAD0(0);
  GLOAD1(1);
  SWRITE0(0);
  LBAR;
  for (int kt = 0; kt < KT; kt += 2) {
    const int k2 = (kt + 2 < KT) ? kt + 2 : KT - 2, k3 = (kt + 3 < KT) ? kt + 3 : KT - 1;
    GLOAD0(k2);
    __builtin_amdgcn_sched_barrier(0);
    FRAGS(0);
    __builtin_amdgcn_sched_barrier(0);
    MMA(0, SWRITE1(1));
    LBAR;
    GLOAD1(k3);
    __builtin_amdgcn_sched_barrier(0);
    FRAGS(1);
    __builtin_amdgcn_sched_barrier(0);
    MMA(1, SWRITE0(0));
    LBAR;
  }
#undef FRAGS
#undef MMA
#undef GLOAD0
#undef GLOAD1
#undef SWRITE0
#undef SWRITE1
#undef GLOAD
#undef SWRITE
#undef LBAR
  if (EPI == EPI_P || EPI == EPI_FF1 || EPI == EPI_Y) {
    bf16_t* Cs = (bf16_t*)smem;
#pragma unroll
    for (int mt = 0; mt < 4; ++mt) {
      const int ml = wm * 64 + mt * 16 + qi;
#pragma unroll
      for (int nt = 0; nt < 4; ++nt) {
        const int nl = wn * 64 + nt * 16 + quad * 4;
        f32x4 v = acc[mt][nt];
        if (EPI == EPI_FF1) {
          float a = fmaxf(v[0], 0.f), b = fmaxf(v[1], 0.f), c = fmaxf(v[2], 0.f), d = fmaxf(v[3], 0.f);
          v[0] = a * a; v[1] = b * b; v[2] = c * c; v[3] = d * d;
        }
        uint2 o; o.x = pack2(v[0], v[1]); o.y = pack2(v[2], v[3]);
        *(uint2*)(Cs + ml * 136 + nl) = o;
      }
    }
    asm volatile("s_waitcnt lgkmcnt(0)" ::: "memory");
    __builtin_amdgcn_s_barrier();
    const int ldo = (EPI == EPI_P) ? 2336 : (EPI == EPI_Y) ? 1024 : 4096;
#pragma unroll
    for (int i = 0; i < 8; ++i) {
      const int id = tid + 256 * i, row = id >> 4, cc = (id & 15) * 8;
      uint4 d = *(const uint4*)(Cs + row * 136 + cc);
      if (EPI != EPI_P || n0 + cc < 2336) *(uint4*)((bf16_t*)out0 + (size_t)(m0 + row) * ldo + n0 + cc) = d;
    }
    return;
  }
  if (false) {
    float* Cf = (float*)smem;
#pragma unroll
    for (int mt = 0; mt < 4; ++mt) {
      const int ml = wm * 64 + mt * 16 + qi;
#pragma unroll
      for (int nt = 0; nt < 4; ++nt) {
        const int nl = wn * 64 + nt * 16 + quad * 4;
        f32x4 v = acc[mt][nt];
        *(float4*)(Cf + ml * 132 + nl) = float4{v[0], v[1], v[2], v[3]};
      }
    }
    asm volatile("s_waitcnt lgkmcnt(0)" ::: "memory");
    __builtin_amdgcn_s_barrier();
#pragma unroll
    for (int i = 0; i < 16; ++i) {
      const int id = tid + 256 * i, row = id >> 5, cc = (id & 31) * 4;
      float4 d = *(const float4*)(Cf + row * 132 + cc);
      *(float4*)((float*)out0 + (size_t)(m0 + row) * 1024 + n0 + cc) = d;
    }
    return;
  }
#pragma unroll
  for (int mt = 0; mt < 4; ++mt) {
    const int ml = wm * 64 + mt * 16 + qi;
    const int m = m0 + ml;
    float r = 1.f;
    if (EPI == EPI_Q || EPI == EPI_KV) r = rs[ml];
#pragma unroll
    for (int nt = 0; nt < 4; ++nt) {
      const int nl = wn * 64 + nt * 16 + quad * 4;
      const int n = n0 + nl;
      f32x4 v = acc[mt][nt];
      if (EPI == EPI_P) {
        if (n < 2336) { uint2 o; o.x = pack2(v[0], v[1]); o.y = pack2(v[2], v[3]); *(uint2*)((bf16_t*)out0 + (size_t)m * 2336 + n) = o; }
      } else if (EPI == EPI_Y) {
        *(float4*)((float*)out0 + (size_t)m * 1024 + n) = float4{v[0], v[1], v[2], v[3]};
      } else if (EPI == EPI_FF1) {
        float a = fmaxf(v[0], 0.f), b = fmaxf(v[1], 0.f), c = fmaxf(v[2], 0.f), d = fmaxf(v[3], 0.f);
        uint2 o; o.x = pack2(a * a, b * b); o.y = pack2(c * c, d * d);
        *(uint2*)((bf16_t*)out0 + (size_t)m * 4096 + n) = o;
      } else if (EPI == EPI_Q) {
        if (n < 576) { uint2 o; o.x = pack2(v[0] * r, v[1] * r); o.y = pack2(v[2] * r, v[3] * r); *(uint2*)((bf16_t*)out0 + (size_t)m * 576 + n) = o; }
      } else if (EPI == EPI_KV) {
        const int h = n0 >> 7, b = m >> 12, t = m & 4095;
        if (nl < 64) {
          uint2 o; o.x = pack2(v[0] * r, v[1] * r); o.y = pack2(v[2] * r, v[3] * r);
          *(uint2*)((bf16_t*)out0 + ((size_t)(b * 6 + h) * 4096 + t) * 64 + nl) = o;
        } else {
          bf16_t* vt = (bf16_t*)out1 + ((size_t)(b * 6 + h) * 64 + (nl - 64)) * 4096 + t;
          vt[0] = f2bf(v[0] * r); vt[4096] = f2bf(v[1] * r); vt[8192] = f2bf(v[2] * r); vt[12288] = f2bf(v[3] * r);
        }
      }
    }
  }
}

template <int EPI>
DI void gemm_phase(const bf16_t* A, int lda, const bf16_t* Bt, int K, int NT, char* smem, void* out0, void* out1) {
  if ((NT & 7) == 0 && gridDim.x == 512) {
    const int xcd = blockIdx.x & 7, j = blockIdx.x >> 3;
    const int nsc = NT >> 3, nsuper = 16 * nsc;
    for (int s = xcd; s < nsuper; s += 8) {
      int sm = s / nsc, sn = s - sm * nsc;
      gemm_tile<EPI>(A, lda, Bt, K, (sm * 8 + (j >> 3)) * 128, (sn * 8 + (j & 7)) * 128, smem, out0, out1);
    }
    return;
  }
  if (gridDim.x == 512) {
    const int xcd = blockIdx.x & 7, j = blockIdx.x >> 3;
    for (int idx = j; idx < 16 * NT; idx += 64) {
      int ml = idx / NT, nt = idx - ml * NT;
      gemm_tile<EPI>(A, lda, Bt, K, (xcd * 16 + ml) * 128, nt * 128, smem, out0, out1);
    }
    return;
  }
  const int total = 128 * NT;
  for (int it = blockIdx.x; it < total; it += gridDim.x) {
    int mt = it / NT, nt = it % NT;
    gemm_tile<EPI>(A, lda, Bt, K, mt * 128, nt * 128, smem, out0, out1);
  }
}

DI float ld_shift(const bf16_t* p, size_t m, int t, int col, float mu) {
  const size_t mp = m - (size_t)(t > 0 ? 1 : 0);
  const bf16_t c16 = p[m * 2336 + col], p16 = p[mp * 2336 + col];
  float cur = bf2f(c16);
  float prev = bf2f(p16);
  prev = (t > 0) ? prev : 0.f;
  return cur + (prev - cur) * mu;
}

DI void prep_rwkv_item(const Params& P, int l, int item, char* smem) {
  bf16_t* ZA = (bf16_t*)smem;
  bf16_t* WB = (bf16_t*)(smem + 17408);
  float* ACC = (float*)smem;
  const bf16_t* p = (const bf16_t*)(P.ws + OFF_P);
  bf16_t* SI = (bf16_t*)(P.ws + OFF_SI);
  bf16_t* ycat = (bf16_t*)(P.ws + OFF_H);
  float* bonus = (float*)(P.ws + OFF_BONUS);
  const int tid = threadIdx.x;
  const int h = item % 6, tt = (item / 6) & 63, b = item / 384;
  const int t0 = tt * 64;
  const float* mu = P.mu + l * 1280;
  __syncthreads();
  {
    const bf16_t* lo = (const bf16_t*)(P.ws + OFF_LORA) + h * 8192;
#pragma unroll
    for (int i = 0; i < 4; ++i) {
      int id = tid + 256 * i; int n = id >> 4, kc = (id & 15) * 8;
      *(uint4*)(WB + n * 136 + kc) = *(const uint4*)(lo + n * 128 + kc);
    }
  }
  const float mu_lo = mu[1152 + (tid & 127)];
#pragma unroll 16
  for (int i = 0; i < 32; ++i) {
    int idx = tid + 256 * i; int tok = idx >> 7, j = idx & 127;
    int t = t0 + tok; size_t m = (size_t)b * 4096 + t;
    float z = ld_shift(p, m, t, 1152 + j, mu_lo);
    const float sg_ = sigmoidf_((j < 32) ? 2.f * z : z);
    z = (j < 32) ? (2.f * sg_ - 1.f) : ((j >= 64) ? sg_ : z);
    ZA[tok * 136 + j] = f2bf(z);
  }
  __syncthreads();
  const int g = tid >> 6, c = tid & 63, col = h * 64 + c;
  {
    const int qi = c & 15, quad = c >> 4;
    bf16x8 af[4];
#pragma unroll
    for (int ks = 0; ks < 4; ++ks) af[ks] = *(const bf16x8*)(ZA + (g * 16 + qi) * 136 + ks * 32 + quad * 8);
    f32x4 cw[4], ca[4], cg2[4];
#pragma unroll
    for (int nt = 0; nt < 4; ++nt) {
      const bf16_t* wb = WB + (nt * 16 + qi) * 136 + quad * 8;
      bf16x8 b0 = *(const bf16x8*)(wb), b1 = *(const bf16x8*)(wb + 32), b2 = *(const bf16x8*)(wb + 64), b3 = *(const bf16x8*)(wb + 96);
      const f32x4 z4 = {0.f, 0.f, 0.f, 0.f};
      cw[nt] = __builtin_amdgcn_mfma_f32_16x16x32_bf16(af[0], b0, z4, 0, 0, 0);
      ca[nt] = __builtin_amdgcn_mfma_f32_16x16x32_bf16(af[1], b1, z4, 0, 0, 0);
      cg2[nt] = __builtin_amdgcn_mfma_f32_16x16x32_bf16(af[2], b2, z4, 0, 0, 0);
      cg2[nt] = __builtin_amdgcn_mfma_f32_16x16x32_bf16(af[3], b3, cg2[nt], 0, 0, 0);
    }
    __syncthreads();
#pragma unroll
    for (int nt = 0; nt < 4; ++nt)
#pragma unroll
      for (int j = 0; j < 4; ++j) {
        const int o = (g * 16 + quad * 4 + j) * 68 + nt * 16 + qi;
        ACC[o] = cw[nt][j]; ACC[64 * 68 + o] = ca[nt][j]; ACC[2 * 64 * 68 + o] = cg2[nt][j];
      }
    asm volatile("s_waitcnt lgkmcnt(0)" ::: "memory");
  }
  const float w0 = P.w0[l * 384 + col], a0 = P.a0[l * 384 + col], kkw = P.k_k[l * 384 + col], kaw = P.k_a[l * 384 + col];
  const float rkw = P.r_k[l * 384 + col];
  const float mu_r = mu[col], mu_k = mu[384 + col], mu_v = mu[768 + col];
#pragma unroll 1
  for (int sub = 0; sub < 4; ++sub) {
    float accw[4], acca[4], accg[4];
    float rsh[4], ksh[4], vsh[4];
#pragma unroll
    for (int i = 0; i < 4; ++i) {
      int t = t0 + g * 16 + sub * 4 + i; size_t m = (size_t)b * 4096 + t;
      rsh[i] = ld_shift(p, m, t, col, mu_r);
      ksh[i] = ld_shift(p, m, t, 384 + col, mu_k);
      vsh[i] = ld_shift(p, m, t, 768 + col, mu_v);
      const int o = (g * 16 + sub * 4 + i) * 68 + c;
      accw[i] = ACC[o]; acca[i] = ACC[64 * 68 + o]; accg[i] = ACC[2 * 64 * 68 + o];
    }
    bf16_t* stg = (bf16_t*)(smem + 52224) + g * 896;
#pragma unroll
    for (int pr = 0; pr < 2; ++pr) {
      float bonv[2];
#pragma unroll
      for (int tk = 0; tk < 2; ++tk) {
        const int i = pr * 2 + tk;
        int t = t0 + g * 16 + sub * 4 + i; size_t m = (size_t)b * 4096 + t;
        float r = rsh[i], k = ksh[i], v = vsh[i];
        float xw = -(w0 + accw[i]);
        float sp = fmaxf(xw, 0.f) + __logf(1.f + __expf(-fabsf(xw)));
        float wl_ = -sp - 0.5f;
        float delta = 1.f - __expf(-__expf(wl_));
        float a = sigmoidf_(a0 + acca[i]);
        float kk = k * kkw;
        float ss = wave_sum(kk * kk);
        kk *= rsqrtf(fmaxf(ss, 1e-24f));
        float k2 = k * (1.f + (a - 1.f) * kaw);
        float bon = wave_sum(r * k2 * rkw);
        bf16_t* sg = stg + tk * 448 + c;
        sg[0] = f2bf(delta); sg[64] = f2bf(k2); sg[128] = f2bf(-kk); sg[192] = f2bf(kk * a); sg[256] = f2bf(r); sg[320] = f2bf(v);
        sg[384] = f2bf(accg[i]);
        bonv[tk] = bon;
      }
      asm volatile("s_waitcnt lgkmcnt(0)" ::: "memory");
#pragma unroll
      for (int tk = 0; tk < 2; ++tk) {
        const int i = pr * 2 + tk;
        int t = t0 + g * 16 + sub * 4 + i; size_t m = (size_t)b * 4096 + t;
        if (c < 56) {
          uint4 d = *(const uint4*)(stg + tk * 448 + c * 8);
          bf16_t* dst = (c < 48) ? (SI + ((size_t)(b * 6 + h) * 4096 + t) * 384 + c * 8) : (ycat + m * 1024 + h * 64 + (c - 48) * 8);
          *(uint4*)dst = d;
        }
        if (c == 56) bonus[m * 6 + h] = bonv[tk];
      }
      asm volatile("s_waitcnt lgkmcnt(0)" ::: "memory");
    }
  }
}

DI void prep_conv_item(const Params& P, int l, int item, char* smem) {
  float* cv = (float*)smem;
  const bf16_t* p = (const bf16_t*)(P.ws + OFF_P);
  bf16_t* ycat = (bf16_t*)(P.ws + OFF_H);
  const int tid = threadIdx.x;
  const int b = item >> 7, t0 = (item & 127) * 32;
  __syncthreads();
  {
    const int c = tid;
    float hw[62];
#pragma unroll
    for (int j = 0; j < 62; ++j) {
      int t = t0 - 30 + j;
      const int tc = t < 0 ? 0 : t;
      size_t m = (size_t)b * 4096 + tc;
      float u = bf2f(p[m * 2336 + 1280 + c]);
      float gt = bf2f(p[m * 2336 + 1536 + c]);
      float hv = u * sigmoidf_(gt);
      hw[j] = (t >= 0) ? hv : 0.f;
    }
    float wj[31];
#pragma unroll
    for (int j = 0; j < 31; ++j) wj[j] = P.conv_w[(size_t)l * 31 * 256 + j * 256 + c];
    const float bias = P.conv_b[l * 256 + c];
#pragma unroll
    for (int i = 0; i < 32; ++i) {
      float o = bias;
#pragma unroll
      for (int j = 0; j < 31; ++j) fmac(o, hw[i + j], wj[j]);
      cv[i * 256 + c] = o;
    }
  }
  __syncthreads();
  const int w = tid >> 6, lane = tid & 63;
  float lnw[4], lnb[4];
#pragma unroll
  for (int q = 0; q < 4; ++q) { lnw[q] = P.cln_w[l * 256 + lane + 64 * q]; lnb[q] = P.cln_b[l * 256 + lane + 64 * q]; }
  for (int i = 0; i < 8; ++i) {
    int tok = w * 8 + i;
    float v[4]; float s = 0;
#pragma unroll
    for (int q = 0; q < 4; ++q) { v[q] = cv[tok * 256 + lane + 64 * q]; s += v[q]; }
    float mean = wave_sum(s) * (1.f / 256.f);
    float s2 = 0;
#pragma unroll
    for (int q = 0; q < 4; ++q) { float d = v[q] - mean; s2 += d * d; }
    float rstd = rsqrtf(wave_sum(s2) * (1.f / 256.f) + 1e-5f);
    size_t m = (size_t)b * 4096 + t0 + tok;
#pragma unroll
    for (int q = 0; q < 4; ++q) {
      int c = lane + 64 * q;
      float yv = (v[q] - mean) * rstd * lnw[q] + lnb[q];
      ycat[m * 1024 + 384 + c] = f2bf(yv * sigmoidf_(yv));
    }
  }
}

DI float rope_inv_freq(int i) { return exp2f(-(float)i * (13.287712379549449f / 16.f)); }
DI void fast_sincos(float ang, float& s, float& c) {
  float n = rintf(ang * 0.15915494309189535f);
  float r = fmaf(-n, 6.2831855f, ang);
  r = fmaf(-n, -1.7484555e-7f, r);
  s = __sinf(r); c = __cosf(r);
}

DI void prep_kpe_item(const Params& P, int item) {
  const bf16_t* p = (const bf16_t*)(P.ws + OFF_P);
  bf16_t* kpe = (bf16_t*)(P.ws + OFF_KPE);
  const int tid = threadIdx.x;
#pragma unroll 8
  for (int i = 0; i < 16; ++i) {
    int idx = tid + 256 * i;
    size_t m = (size_t)item * 256 + (idx >> 4); int fi = idx & 15;
    float x1 = bf2f(p[m * 2336 + 2304 + fi]), x2 = bf2f(p[m * 2336 + 2320 + fi]);
    float ang = (float)P.pos[m] * rope_inv_freq(fi);
    float cs, sn; fast_sincos(ang, sn, cs);
    kpe[m * 32 + fi] = f2bf(x1 * cs - x2 * sn);
    kpe[m * 32 + 16 + fi] = f2bf(x2 * cs + x1 * sn);
  }
}

constexpr int SCAN_BUF = 16 * 5 * 64 + 256;

DI void scan_chunk(const float* bb, const float* vb, int kq, float& S0, float& S1, float& S2, float& S3, float& ykeep) {
  float4 decA, kvA, avA, bvA, rvA, decB, kvB, avB, bvB, rvB, decC, kvC, avC, bvC, rvC;
  float vvA, vvB, vvC;
  float4 rprev = {0.f, 0.f, 0.f, 0.f};
#define LDSTEP(X, s)                                                                                      \
  {                                                                                                       \
    const float* bn = bb + (s) * 320;                                                                     \
    dec##X = *(const float4*)(bn + 0 * 64); kv##X = *(const float4*)(bn + 1 * 64);                        \
    av##X = *(const float4*)(bn + 2 * 64); bv##X = *(const float4*)(bn + 3 * 64);                         \
    rv##X = *(const float4*)(bn + 4 * 64); vv##X = vb[(s) * 16];                                          \
  }
#define STEP(s, X, PF)                                                                                    \
  {                                                                                                       \
    if ((s) + 2 < 16) LDSTEP(PF, (s) + 2)                                                                 \
    float sa, yv, t0, t1, t2, t3;                                                                         \
    asm volatile(                                                                                         \
        "v_mul_f32 %4, %0, %10\n\t"                                                                       \
        "v_mul_f32 %5, %0, %26\n\t"                                                                       \
        "v_fmac_f32 %4, %1, %11\n\t"                                                                      \
        "v_fmac_f32 %5, %1, %27\n\t"                                                                      \
        "v_fmac_f32 %4, %2, %12\n\t"                                                                      \
        "v_fmac_f32 %5, %2, %28\n\t"                                                                      \
        "v_fmac_f32 %4, %3, %13\n\t"                                                                      \
        "v_fmac_f32 %5, %3, %29\n\t"                                                                      \
        "v_mul_f32 %6, %0, %14\n\t"                                                                       \
        "v_mul_f32 %7, %1, %15\n\t"                                                                       \
        "v_add_f32_dpp %4, %4, %4 quad_perm:[1,0,3,2] row_mask:0xf bank_mask:0xf bound_ctrl:1\n\t"        \
        "v_add_f32_dpp %5, %5, %5 quad_perm:[1,0,3,2] row_mask:0xf bank_mask:0xf bound_ctrl:1\n\t"        \
        "v_mul_f32 %8, %2, %16\n\t"                                                                       \
        "v_add_f32_dpp %4, %4, %4 quad_perm:[2,3,0,1] row_mask:0xf bank_mask:0xf bound_ctrl:1\n\t"        \
        "v_add_f32_dpp %5, %5, %5 quad_perm:[2,3,0,1] row_mask:0xf bank_mask:0xf bound_ctrl:1\n\t"        \
        "v_mul_f32 %9, %3, %17\n\t"                                                                       \
        "v_add_f32_dpp %4, %4, %4 row_half_mirror row_mask:0xf bank_mask:0xf bound_ctrl:1\n\t"            \
        "v_add_f32_dpp %5, %5, %5 row_half_mirror row_mask:0xf bank_mask:0xf bound_ctrl:1\n\t"            \
        "v_fmac_f32 %6, %30, %18\n\t"                                                                     \
        "v_add_f32_dpp %4, %4, %4 row_mirror row_mask:0xf bank_mask:0xf bound_ctrl:1\n\t"                 \
        "v_add_f32_dpp %5, %5, %5 row_mirror row_mask:0xf bank_mask:0xf bound_ctrl:1\n\t"                 \
        "v_fmac_f32 %7, %30, %19\n\t"                                                                     \
        "v_fmac_f32 %8, %30, %20\n\t"                                                                     \
        "v_fmac_f32 %9, %30, %21\n\t"                                                                     \
        "v_fma_f32 %0, %4, %22, %6\n\t"                                                                   \
        "v_fma_f32 %1, %4, %23, %7\n\t"                                                                   \
        "v_fma_f32 %2, %4, %24, %8\n\t"                                                                   \
        "v_fma_f32 %3, %4, %25, %9\n\t"                                                                   \
        : "+v"(S0), "+v"(S1), "+v"(S2), "+v"(S3), "=&v"(sa), "=&v"(yv), "=&v"(t0), "=&v"(t1), "=&v"(t2), "=&v"(t3) \
        : "v"(av##X.x), "v"(av##X.y), "v"(av##X.z), "v"(av##X.w),                                         \
          "v"(dec##X.x), "v"(dec##X.y), "v"(dec##X.z), "v"(dec##X.w),                                     \
          "v"(kv##X.x), "v"(kv##X.y), "v"(kv##X.z), "v"(kv##X.w),                                         \
          "v"(bv##X.x), "v"(bv##X.y), "v"(bv##X.z), "v"(bv##X.w),                                         \
          "v"(rprev.x), "v"(rprev.y), "v"(rprev.z), "v"(rprev.w), "v"(vv##X));                            \
    if ((s) > 0) ykeep = (kq == (s) - 1) ? yv : ykeep;                                                    \
    rprev = rv##X;                                                                                        \
  }
  LDSTEP(A, 0) LDSTEP(B, 1)
  STEP(0, A, C) STEP(1, B, A) STEP(2, C, B) STEP(3, A, C) STEP(4, B, A) STEP(5, C, B)
  STEP(6, A, C) STEP(7, B, A) STEP(8, C, B) STEP(9, A, C) STEP(10, B, A) STEP(11, C, B)
  STEP(12, A, C) STEP(13, B, A) STEP(14, C, B) STEP(15, A, C)
#undef STEP
#undef LDSTEP
  {
    float yv = S0 * rprev.x;
    yv = fmaf(S1, rprev.y, yv); yv = fmaf(S2, rprev.z, yv); yv = fmaf(S3, rprev.w, yv);
    yv = allreduce16(yv);
    ykeep = (kq == 15) ? yv : ykeep;
  }
}

DI void scan_store8(float* d, uint4 r, int mode) {
  float f0 = bflo(r.x), f1 = bfhi(r.x), f2 = bflo(r.y), f3 = bfhi(r.y);
  float f4 = bflo(r.z), f5 = bfhi(r.z), f6 = bflo(r.w), f7 = bfhi(r.w);
  if (mode == 2) { f0 = 1.f - f0; f1 = 1.f - f1; f2 = 1.f - f2; f3 = 1.f - f3; f4 = 1.f - f4; f5 = 1.f - f5; f6 = 1.f - f6; f7 = 1.f - f7; }
  if (mode) { *(float4*)d = float4{f0, f1, f2, f3}; *(float4*)(d + 4) = float4{f4, f5, f6, f7}; }
}

DI void scan_item(const Params& P, int item, char* smem) {
  float* buf = (float*)smem;
  const int tid = threadIdx.x;
  const int qr = item & 3, h = (item >> 2) % 6, b = item / 24;
  const bf16_t* SI = (const bf16_t*)(P.ws + OFF_SI) + (size_t)(b * 6 + h) * 4096 * 384;
  float* yraw = (float*)(P.ws + OFF_YRAW) + (size_t)b * 4096 * 1168 + h * 64 + qr * 16;
  const int kq = tid & 15, rowl = tid >> 4;
  int off0, off1, off2, md0, md1, md2;
#define SCAN_CONST(i, OFF, MD)                                                           \
  {                                                                                      \
    int e = (tid + 256 * (i)) * 8; int step = e / 384; int within = e - step * 384;      \
    int vec = within >> 6, c0 = within & 63;                                             \
    if (vec < 5) { OFF = (step * 5 + vec) * 64 + c0; MD = (vec == 0) ? 2 : 1; }          \
    else if ((c0 >> 4) == qr) { OFF = 5120 + step * 16 + (c0 & 15); MD = 1; }            \
    else { OFF = 0; MD = 0; }                                                            \
  }
  SCAN_CONST(0, off0, md0) SCAN_CONST(1, off1, md1) SCAN_CONST(2, off2, md2)
#undef SCAN_CONST
  const bf16_t* sp = SI + tid * 8;
  uint4 a0, a1, a2, b0, b1, b2, c0, c1, c2, d0, d1, d2;
#define SLOAD(ch, R0, R1, R2) { const bf16_t* q_ = sp + (size_t)(ch) * 6144; R0 = *(const uint4*)q_; R1 = *(const uint4*)(q_ + 2048); R2 = *(const uint4*)(q_ + 4096); }
#define SSTORE(bi, R0, R1, R2) { float* d_ = buf + (bi) * SCAN_BUF; scan_store8(d_ + off0, R0, md0); scan_store8(d_ + off1, R1, md1); scan_store8(d_ + off2, R2, md2); }
#define LBAR { asm volatile("s_waitcnt lgkmcnt(0)" ::: "memory"); __builtin_amdgcn_s_barrier(); }
  __syncthreads();
  SLOAD(0, a0, a1, a2) SLOAD(1, b0, b1, b2) SLOAD(2, c0, c1, c2) SLOAD(3, d0, d1, d2)
  SSTORE(0, a0, a1, a2)
  LBAR
  float S0 = 0.f, S1 = 0.f, S2 = 0.f, S3 = 0.f;
  const float* bb0 = buf + kq * 4;
  const float* bb1 = buf + SCAN_BUF + kq * 4;
  const float* vb0 = buf + 5120 + rowl;
  const float* vb1 = buf + SCAN_BUF + 5120 + rowl;
  float* yp = yraw + (size_t)kq * 1168 + rowl;
  for (int ch = 0; ch < 256; ch += 4) {
    float yk;
    const int n4 = (ch + 4 < 256) ? ch + 4 : 255, n5 = (ch + 5 < 256) ? ch + 5 : 255;
    const int n6 = (ch + 6 < 256) ? ch + 6 : 255, n7 = (ch + 7 < 256) ? ch + 7 : 255;
    yk = 0.f; scan_chunk(bb0, vb0, kq, S0, S1, S2, S3, yk);
    yp[(size_t)(ch + 0) * 16 * 1168] = yk;
    SSTORE(1, b0, b1, b2) SLOAD(n4, a0, a1, a2) LBAR
    yk = 0.f; scan_chunk(bb1, vb1, kq, S0, S1, S2, S3, yk);
    yp[(size_t)(ch + 1) * 16 * 1168] = yk;
    SSTORE(0, c0, c1, c2) SLOAD(n5, b0, b1, b2) LBAR
    yk = 0.f; scan_chunk(bb0, vb0, kq, S0, S1, S2, S3, yk);
    yp[(size_t)(ch + 2) * 16 * 1168] = yk;
    SSTORE(1, d0, d1, d2) SLOAD(n6, c0, c1, c2) LBAR
    yk = 0.f; scan_chunk(bb1, vb1, kq, S0, S1, S2, S3, yk);
    yp[(size_t)(ch + 3) * 16 * 1168] = yk;
    SSTORE(0, a0, a1, a2) SLOAD(n7, d0, d1, d2) LBAR
  }
#undef SLOAD
#undef SSTORE
#undef LBAR
}

DI void load_q(const int* __restrict__ pos, const bf16_t* __restrict__ Q, int b, int h, int t, int quad, float qscale,
               bf16x8& f0, bf16x8& f1, bf16x8& f2) {
  const bf16_t* qrow = Q + ((size_t)b * 4096 + t) * 576 + h * 96;
  {
    uint4 v = *(const uint4*)(qrow + quad * 8);
    uint4 o;
    o.x = pack2(bflo(v.x) * qscale, bfhi(v.x) * qscale); o.y = pack2(bflo(v.y) * qscale, bfhi(v.y) * qscale);
    o.z = pack2(bflo(v.z) * qscale, bfhi(v.z) * qscale); o.w = pack2(bflo(v.w) * qscale, bfhi(v.w) * qscale);
    f0 = __builtin_bit_cast(bf16x8, o);
  }
  {
    uint4 v = *(const uint4*)(qrow + 32 + quad * 8);
    uint4 o;
    o.x = pack2(bflo(v.x) * qscale, bfhi(v.x) * qscale); o.y = pack2(bflo(v.y) * qscale, bfhi(v.y) * qscale);
    o.z = pack2(bflo(v.z) * qscale, bfhi(v.z) * qscale); o.w = pack2(bflo(v.w) * qscale, bfhi(v.w) * qscale);
    f1 = __builtin_bit_cast(bf16x8, o);
  }
  {
    uint4 v = *(const uint4*)(qrow + 64 + quad * 8);
    uint4 u = *(const uint4*)(qrow + 64 + (quad ^ 2) * 8);
    const float posf = (float)pos[(size_t)b * 4096 + t];
    const float sgn = (quad < 2) ? -1.f : 1.f;
    const int fb = (quad & 1) * 8;
    uint4 o;
#define ROPE2(dst, vs, us, j0)                                                                 \
    {                                                                                          \
      float c0, s0, c1, s1;                                                                    \
      fast_sincos(posf * rope_inv_freq(fb + (j0)), s0, c0);                                    \
      fast_sincos(posf * rope_inv_freq(fb + (j0) + 1), s1, c1);                                \
      dst = pack2((bflo(vs) * c0 + sgn * bflo(us) * s0) * qscale, (bfhi(vs) * c1 + sgn * bfhi(us) * s1) * qscale); \
    }
    ROPE2(o.x, v.x, u.x, 0) ROPE2(o.y, v.y, u.y, 2) ROPE2(o.z, v.z, u.z, 4) ROPE2(o.w, v.w, u.w, 6)
#undef ROPE2
    f2 = __builtin_bit_cast(bf16x8, o);
  }
}

DI void attn_item(const Params& P, int item, char* smem) {
  bf16_t* Ks = (bf16_t*)smem;
  bf16_t* Vs = Ks + 2 * 64 * 104;
  const int tid = threadIdx.x, lane = tid & 63, w = tid >> 6, qi = lane & 15, quad = lane >> 4;
  const int qb = 31 - item / 24, bh = item % 24, b = bh / 6, h = bh % 6;
  const bf16_t* Q = (const bf16_t*)(P.ws + OFF_Q);
  const bf16_t* Kn = (const bf16_t*)(P.ws + OFF_KN) + (size_t)bh * 4096 * 64;
  const bf16_t* Kpe = (const bf16_t*)(P.ws + OFF_KPE) + (size_t)b * 4096 * 32;
  const bf16_t* Vt = (const bf16_t*)(P.ws + OFF_VT) + (size_t)bh * 64 * 4096;
  bf16_t* ycat = (bf16_t*)(P.ws + OFF_H);
  const int q0 = qb * 128 + w * 32;
  const float qscale = 0.10206207261596575f * 1.4426950408889634f;
  __syncthreads();
  bf16x8 qfA0, qfA1, qfA2, qfB0, qfB1, qfB2;
  load_q(P.pos, Q, b, h, q0 + qi, quad, qscale, qfA0, qfA1, qfA2);
  load_q(P.pos, Q, b, h, q0 + 16 + qi, quad, qscale, qfB0, qfB1, qfB2);
  f32x4 oacc[4][2];
#pragma unroll
  for (int i = 0; i < 4; ++i) { oacc[i][0] = f32x4{0.f, 0.f, 0.f, 0.f}; oacc[i][1] = f32x4{0.f, 0.f, 0.f, 0.f}; }
  float mrun[2] = {-1e30f, -1e30f}, lrun[2] = {0.f, 0.f};
  const int nkt = (qb + 1) * 2;
  uint4 rk0, rk1, rk2, rv0, rv1;
  const int a_r0 = tid >> 3, a_c0 = (tid & 7) * 8;
  const int a_r2 = tid >> 2, a_c2 = (tid & 3) * 8;
#define ALOAD(kt)                                                                         \
  {                                                                                       \
    rk0 = *(const uint4*)(Kn + ((size_t)(kt) * 64 + a_r0) * 64 + a_c0);                   \
    rk1 = *(const uint4*)(Kn + ((size_t)(kt) * 64 + a_r0 + 32) * 64 + a_c0);              \
    rv0 = *(const uint4*)(Vt + (size_t)a_r0 * 4096 + (kt) * 64 + a_c0);                   \
    rv1 = *(const uint4*)(Vt + (size_t)(a_r0 + 32) * 4096 + (kt) * 64 + a_c0);            \
    rk2 = *(const uint4*)(Kpe + ((size_t)(kt) * 64 + a_r2) * 32 + a_c2);                  \
  }
#define ASTORE(bi)                                                                        \
  {                                                                                       \
    *(uint4*)(Ks + ((bi) * 64 + a_r0) * 104 + a_c0) = rk0;                                \
    *(uint4*)(Ks + ((bi) * 64 + a_r0 + 32) * 104 + a_c0) = rk1;                           \
    *(uint4*)(Vs + ((bi) * 64 + a_r0) * 72 + a_c0) = rv0;                                 \
    *(uint4*)(Vs + ((bi) * 64 + a_r0 + 32) * 72 + a_c0) = rv1;                            \
    *(uint4*)(Ks + ((bi) * 64 + a_r2) * 104 + 64 + a_c2) = rk2;                           \
  }
  ALOAD(0);
  ASTORE(0);
  __syncthreads();
  for (int kt = 0; kt < nkt; ++kt) {
    const int cur = kt & 1;
    if (kt + 1 < nkt) ALOAD(kt + 1);
    if (kt * 64 <= q0 + 31) {
      const bf16_t* ks_ = Ks + cur * 64 * 104;
      const bf16_t* vs_ = Vs + cur * 64 * 72;
      f32x4 st[4][2];
#pragma unroll
      for (int i = 0; i < 4; ++i) { st[i][0] = f32x4{0.f, 0.f, 0.f, 0.f}; st[i][1] = f32x4{0.f, 0.f, 0.f, 0.f}; }
#define QK_STEP(ks, QA, QB)                                                                          \
      _Pragma("unroll") for (int kti = 0; kti < 4; ++kti) {                                          \
        bf16x8 kf = *(const bf16x8*)(ks_ + (kti * 16 + qi) * 104 + (ks) * 32 + quad * 8);           \
        st[kti][0] = __builtin_amdgcn_mfma_f32_16x16x32_bf16(kf, QA, st[kti][0], 0, 0, 0);           \
        st[kti][1] = __builtin_amdgcn_mfma_f32_16x16x32_bf16(kf, QB, st[kti][1], 0, 0, 0);           \
      }
      QK_STEP(0, qfA0, qfB0)
      QK_STEP(1, qfA1, qfB1)
      QK_STEP(2, qfA2, qfB2)
#undef QK_STEP
      const bool need_mask = (kt * 64 + 63 > q0);
#pragma unroll
      for (int qt = 0; qt < 2; ++qt) {
        const int qq = q0 + qt * 16 + qi;
        if (need_mask) {
#pragma unroll
          for (int kti = 0; kti < 4; ++kti)
#pragma unroll
            for (int j = 0; j < 4; ++j) {
              int key = kt * 64 + kti * 16 + quad * 4 + j;
              if (key > qq) st[kti][qt][j] = -1e30f;
            }
        }
        float mx = -1e30f;
#pragma unroll
        for (int kti = 0; kti < 4; ++kti)
#pragma unroll
          for (int j = 0; j < 4; ++j) mx = fmaxf(mx, st[kti][qt][j]);
        mx = fmaxf(mx, __shfl_xor(mx, 16));
        mx = fmaxf(mx, __shfl_xor(mx, 32));
        const float mnew = fmaxf(mrun[qt], mx);
        const float alpha = exp2f(mrun[qt] - mnew);
        float ls = 0.f;
#pragma unroll
        for (int kti = 0; kti < 4; ++kti)
#pragma unroll
          for (int j = 0; j < 4; ++j) { float pv = exp2f(st[kti][qt][j] - mnew); st[kti][qt][j] = pv; ls += pv; }
        lrun[qt] = lrun[qt] * alpha + ls;
        mrun[qt] = mnew;
#pragma unroll
        for (int d = 0; d < 4; ++d) { oacc[d][qt][0] *= alpha; oacc[d][qt][1] *= alpha; oacc[d][qt][2] *= alpha; oacc[d][qt][3] *= alpha; }
      }
#pragma unroll
      for (int k2 = 0; k2 < 2; ++k2) {
        bf16x8 pf[2];
#pragma unroll
        for (int qt = 0; qt < 2; ++qt) {
          uint4 o;
          o.x = pack2(st[k2 * 2][qt][0], st[k2 * 2][qt][1]); o.y = pack2(st[k2 * 2][qt][2], st[k2 * 2][qt][3]);
          o.z = pack2(st[k2 * 2 + 1][qt][0], st[k2 * 2 + 1][qt][1]); o.w = pack2(st[k2 * 2 + 1][qt][2], st[k2 * 2 + 1][qt][3]);
          pf[qt] = __builtin_bit_cast(bf16x8, o);
        }
#pragma unroll
        for (int d = 0; d < 4; ++d) {
          const bf16_t* vp = vs_ + (d * 16 + qi) * 72 + k2 * 32 + quad * 4;
          uint2 lo = *(const uint2*)vp, hi = *(const uint2*)(vp + 16);
          uint4 vv; vv.x = lo.x; vv.y = lo.y; vv.z = hi.x; vv.w = hi.y;
          bf16x8 vf = __builtin_bit_cast(bf16x8, vv);
          oacc[d][0] = __builtin_amdgcn_mfma_f32_16x16x32_bf16(vf, pf[0], oacc[d][0], 0, 0, 0);
          oacc[d][1] = __builtin_amdgcn_mfma_f32_16x16x32_bf16(vf, pf[1], oacc[d][1], 0, 0, 0);
        }
      }
    }
    if (kt + 1 < nkt) ASTORE(cur ^ 1);
    __syncthreads();
  }
#undef ALOAD
#undef ASTORE
#pragma unroll
  for (int qt = 0; qt < 2; ++qt) {
    float l = lrun[qt];
    l += __shfl_xor(l, 16);
    l += __shfl_xor(l, 32);
    const float inv = 1.f / l;
    const size_t m = (size_t)b * 4096 + q0 + qt * 16 + qi;
#pragma unroll
    for (int d = 0; d < 4; ++d) {
      uint2 o; o.x = pack2(oacc[d][qt][0] * inv, oacc[d][qt][1] * inv); o.y = pack2(oacc[d][qt][2] * inv, oacc[d][qt][3] * inv);
      *(uint2*)(ycat + m * 1024 + 640 + h * 64 + d * 16 + quad * 4) = o;
    }
  }
}

DI void post_phase(const Params& P, int l) {
  const float* yraw = (const float*)(P.ws + OFF_YRAW);
  const bf16_t* SI = (const bf16_t*)(P.ws + OFF_SI);
  const float* bonus = (const float*)(P.ws + OFF_BONUS);
  bf16_t* ycat = (bf16_t*)(P.ws + OFF_H);
  const int lane = threadIdx.x & 63, w = threadIdx.x >> 6;
  float lnw[6], lnb[6];
#pragma unroll
  for (int h = 0; h < 6; ++h) { lnw[h] = P.rln_w[l * 384 + h * 64 + lane]; lnb[h] = P.rln_b[l * 384 + h * 64 + lane]; }
  for (int m = blockIdx.x * 4 + w; m < 16384; m += gridDim.x * 4) {
    const int b = m >> 12, t = m & 4095;
    float y[6], v[6], g[6], bo[6];
#pragma unroll
    for (int h = 0; h < 6; ++h) {
      y[h] = yraw[(size_t)m * 1168 + h * 64 + lane];
      v[h] = bf2f(SI[((size_t)(b * 6 + h) * 4096 + t) * 384 + 320 + lane]);
      g[h] = bf2f(ycat[(size_t)m * 1024 + h * 64 + lane]);
      bo[h] = bonus[(size_t)m * 6 + h];
    }
#pragma unroll
    for (int h = 0; h < 6; ++h) {
      float mean = wave_sum(y[h]) * (1.f / 64.f);
      float d = y[h] - mean;
      float var = wave_sum(d * d) * (1.f / 64.f);
      float yn = d * rsqrtf(var + 64e-5f) * lnw[h] + lnb[h];
      float o = (yn + bo[h] * v[h]) * g[h];
      ycat[(size_t)m * 1024 + h * 64 + lane] = f2bf(o);
    }
  }
}

template <int PH>
DI void run_phase(const Params& P, char* smem, int* s_item, const XcdBarrier& xb) {
  char* ws = P.ws;
  float* mod = (float*)(ws + OFF_MOD);
  int* cnt = (int*)(ws + OFF_CNT);
  bf16_t* Hb = (bf16_t*)(ws + OFF_H);
  if (PH == 0) {
    if (blockIdx.x == 0 && threadIdx.x < 64) cnt[threadIdx.x] = 0;
    mod_items(P, smem);
    convert_layer(P, 0, smem);
    return;
  }
  if (PH == NPHASE - 1) {
    const float* m1 = mod + (size_t)(1 * 4) * 6144;
    row_pass(P.out, (const bf16_t*)(ws + OFF_Y), m1 + 5 * 1024, P.g_post_ffn + 1024, P.out, nullptr, nullptr, nullptr, nullptr);
    return;
  }
  constexpr int l = (PH - 1) / 9, sub = (PH - 1) % 9;
  const float* ml = mod + (size_t)(l * 4) * 6144;
  if (sub == 0) {
    if (l == 0) {
      row_pass(P.x, nullptr, nullptr, nullptr, nullptr, P.g_pre_mix, ml + 1024, ml, Hb);
    } else {
      convert_layer(P, l, smem);
      const float* mp = mod + (size_t)((l - 1) * 4) * 6144;
      row_pass(P.out, (const bf16_t*)(ws + OFF_Y), mp + 5 * 1024, P.g_post_ffn + (l - 1) * 1024, P.out,
               P.g_pre_mix + l * 1024, ml + 1024, ml, Hb);
    }
  } else if (sub == 1) {
    for (int rep = 0; rep < 1 + ((PROBE_REP >> 0) & 1); ++rep)
    gemm_phase<EPI_P>(Hb, 1024, (const bf16_t*)(ws + OFF_WIN), 1024, 19, smem, ws + OFF_P, nullptr);
  } else if (sub == 2) {
    for (int i = blockIdx.x; i < 1536; i += gridDim.x) prep_rwkv_item(P, l, i, smem);
  } else if (sub == 3) {
    const int NS = 96, G = gridDim.x;
    unsigned* sub_ctr = (unsigned*)&cnt[8 + l];
    if (G >= 2 * NS) {
      if ((int)blockIdx.x < NS) {
        __builtin_amdgcn_s_setprio(3);
        scan_item(P, blockIdx.x, smem);
        __builtin_amdgcn_s_setprio(0);
        sub_barrier_wait(sub_ctr, (unsigned)(G - NS));
      } else {
        const int G2 = G - NS, b2 = blockIdx.x - NS;
        for (int i = b2; i < 768; i += G2)
          gemm_tile<EPI_KV>((const bf16_t*)(ws + OFF_P) + 2048, 2336, (const bf16_t*)(ws + OFF_WUKV), 256, (i / 6) * 128, (i % 6) * 128, smem, ws + OFF_KN, ws + OFF_VT);
        int bid = (b2 + G2 - (768 % G2)) % G2;
        for (int i = bid; i < 640; i += G2)
          gemm_tile<EPI_Q>((const bf16_t*)(ws + OFF_P) + 1792, 2336, (const bf16_t*)(ws + OFF_WUQ), 256, (i / 5) * 128, (i % 5) * 128, smem, ws + OFF_Q, nullptr);
        bid = (b2 + G2 - ((768 + 640) % G2)) % G2;
        for (int i = bid; i < 512; i += G2) prep_conv_item(P, l, i, smem);
        bid = (b2 + G2 - ((768 + 640 + 512) % G2)) % G2;
        for (int i = bid; i < 64; i += G2) prep_kpe_item(P, i);
        sub_barrier(sub_ctr, (unsigned)G2);
      }
    } else {
      for (int i = blockIdx.x; i < 768; i += G)
        gemm_tile<EPI_KV>((const bf16_t*)(ws + OFF_P) + 2048, 2336, (const bf16_t*)(ws + OFF_WUKV), 256, (i / 6) * 128, (i % 6) * 128, smem, ws + OFF_KN, ws + OFF_VT);
      for (int i = blockIdx.x; i < 640; i += G)
        gemm_tile<EPI_Q>((const bf16_t*)(ws + OFF_P) + 1792, 2336, (const bf16_t*)(ws + OFF_WUQ), 256, (i / 5) * 128, (i % 5) * 128, smem, ws + OFF_Q, nullptr);
      for (int i = blockIdx.x; i < 512; i += G) prep_conv_item(P, l, i, smem);
      for (int i = blockIdx.x; i < 64; i += G) prep_kpe_item(P, i);
      for (int it = blockIdx.x; it < NS; it += G) scan_item(P, it, smem);
      xcd_barrier(xb);
    }
    while (true) {
      __syncthreads();
      if (threadIdx.x == 0) *s_item = atomicAdd(&cnt[l], 1);
      __syncthreads();
      int item = *s_item;
      if (item >= 768) break;
      attn_item(P, item, smem);
    }
  } else if (sub == 4) {
    post_phase(P, l);
  } else if (sub == 5) {
    for (int rep = 0; rep < 1 + ((PROBE_REP >> 3) & 1); ++rep)
    gemm_phase<EPI_Y>(Hb, 1024, (const bf16_t*)(ws + OFF_WOUT), 1024, 8, smem, ws + OFF_Y, nullptr);
  } else if (sub == 6) {
    const float* xs = (l == 0) ? P.x : P.out;
    row_pass(xs, (const bf16_t*)(ws + OFF_Y), ml + 2 * 1024, P.g_post_mix + l * 1024, P.out,
             P.g_pre_ffn + l * 1024, ml + 4 * 1024, ml + 3 * 1024, Hb);
  } else if (sub == 7) {
    for (int rep = 0; rep < 1 + ((PROBE_REP >> 4) & 1); ++rep)
    gemm_phase<EPI_FF1>(Hb, 1024, (const bf16_t*)(ws + OFF_WFF1), 1024, 32, smem, ws + OFF_HID, nullptr);
  } else if (sub == 8) {
    for (int rep = 0; rep < 1 + ((PROBE_REP >> 5) & 1); ++rep)
    gemm_phase<EPI_Y>((const bf16_t*)(ws + OFF_HID), 4096, (const bf16_t*)(ws + OFF_WFF2), 4096, 8, smem, ws + OFF_Y, nullptr);
  }
}

__global__ void __launch_bounds__(256, 2) fwd_kernel(Params P, int ph_begin, int ph_end, int use_cg) {
  __shared__ __attribute__((aligned(16))) char smem[74752];
  __shared__ int s_item;
  __shared__ uint4 xb_words;
  cg::grid_group grid = cg::this_grid();
  if (threadIdx.x == 0) xb_words = make_uint4(0u, 0u, 0u, 0u);
  __syncthreads();
  XcdBarrier xb = xcd_barrier_post((unsigned*)(P.ws + OFF_BAR), (volatile LAS unsigned*)&xb_words);
#define RUN(k) if (ph_begin <= (k) && (k) < ph_end) { if ((k) > ph_begin) { if (use_cg) grid.sync(); else xcd_barrier(xb); } run_phase<(k)>(P, smem, &s_item, xb); }
  RUN(0) RUN(1) RUN(2) RUN(3) RUN(4) RUN(5) RUN(6) RUN(7) RUN(8) RUN(9)
  RUN(10) RUN(11) RUN(12) RUN(13) RUN(14) RUN(15) RUN(16) RUN(17) RUN(18) RUN(19)
#undef RUN
}

extern "C" void kernel_launch(void* const* d_in, const int* in_sizes, int n_in, void* d_out, int out_size, void* d_ws,
                              size_t ws_size, hipStream_t stream) {
  Params P{};
  P.x = (const float*)d_in[0]; P.c = (const float*)d_in[1]; P.pos = (const int*)d_in[2];
  P.g_pre_mix = (const float*)d_in[3]; P.g_post_mix = (const float*)d_in[4]; P.g_pre_ffn = (const float*)d_in[5];
  P.g_post_ffn = (const float*)d_in[6]; P.w_ada = (const float*)d_in[7]; P.b_ada = (const float*)d_in[8];
  P.w_in = (const float*)d_in[9]; P.w_out = (const float*)d_in[10];
  P.mu = (const float*)d_in[11]; P.w0 = (const float*)d_in[12]; P.w2 = (const float*)d_in[13]; P.a0 = (const float*)d_in[14];
  P.a2 = (const float*)d_in[15]; P.g2 = (const float*)d_in[16]; P.k_k = (const float*)d_in[17]; P.k_a = (const float*)d_in[18];
  P.r_k = (const float*)d_in[19]; P.rln_w = (const float*)d_in[20]; P.rln_b = (const float*)d_in[21];
  P.conv_w = (const float*)d_in[22]; P.conv_b = (const float*)d_in[23]; P.cln_w = (const float*)d_in[24]; P.cln_b = (const float*)d_in[25];
  P.q_norm = (const float*)d_in[26]; P.w_uq = (const float*)d_in[27]; P.kv_norm = (const float*)d_in[28]; P.w_ukv = (const float*)d_in[29];
  P.w_ff1 = (const float*)d_in[30]; P.w_ff2 = (const float*)d_in[31];
  P.out = (float*)d_out; P.ws = (char*)d_ws;
  static int grid_blocks = 0;
  if (!grid_blocks) {
    int dev = 0, cus = 0, per_cu = 0;
    hipGetDevice(&dev);
    hipDeviceGetAttribute(&cus, hipDeviceAttributeMultiprocessorCount, dev);
    hipOccupancyMaxActiveBlocksPerMultiprocessor(&per_cu, fwd_kernel, 256, 0);
    if (per_cu < 1) per_cu = 1;
    if (per_cu > 2) per_cu = 2;
    grid_blocks = cus * per_cu;
  }
#if SINGLE_LAUNCH
  int pb = 0, pe = NPHASE, ucg = 0;
  hipMemsetAsync((char*)d_ws + OFF_BAR, 0, XCD_BAR_WORDS * 4, stream);
  void* args[] = {&P, &pb, &pe, &ucg};
  hipError_t e = hipLaunchCooperativeKernel((void*)fwd_kernel, dim3(grid_blocks), dim3(256), args, 0, stream);
  if (e != hipSuccess) fprintf(stderr, "cooperative launch failed: %s (grid %d)\n", hipGetErrorString(e), grid_blocks);
#else
  for (int ph = 0; ph < NPHASE; ++ph) fwd_kernel<<<grid_blocks, 256, 0, stream>>>(P, ph, ph + 1, 0);
#endif
}
```

```cpp
#include <hip/hip_runtime.h>
#include <hip/hip_cooperative_groups.h>
#include <cstdio>
namespace cg = cooperative_groups;

#ifndef SINGLE_LAUNCH
#define SINGLE_LAUNCH 1
#endif

#ifndef PROBE_SPLIT
#define PROBE_SPLIT 0
#endif
#ifndef PROBE_PREP
#define PROBE_PREP 0
#endif
#ifndef PROBE_REP
#define PROBE_REP 0
#endif
#define DI __device__ __forceinline__
typedef unsigned short bf16_t;
using bf16x8 = __attribute__((ext_vector_type(8))) short;
using f32x4 = __attribute__((ext_vector_type(4))) float;
using f32x2 = __attribute__((ext_vector_type(2))) float;

constexpr int T_SEQ = 4096;
constexpr int NPHASE = 20;

constexpr size_t OFF_WIN = 0;
constexpr size_t OFF_WOUT = OFF_WIN + 2432ull * 1024 * 2;
constexpr size_t OFF_WFF1 = OFF_WOUT + 1024ull * 1024 * 2;
constexpr size_t OFF_WFF2 = OFF_WFF1 + 4096ull * 1024 * 2;
constexpr size_t OFF_WUQ = OFF_WFF2 + 4096ull * 1024 * 2;
constexpr size_t OFF_WUKV = OFF_WUQ + 640ull * 256 * 2;
constexpr size_t OFF_MISC = OFF_WUKV + 768ull * 256 * 2;
constexpr size_t OFF_MOD = OFF_MISC;
constexpr size_t OFF_BONUS = OFF_MISC + 262144;
constexpr size_t OFF_LORA = OFF_MISC + 655360;
constexpr size_t OFF_CNT = OFF_MISC + 786432;
constexpr size_t OFF_BAR = OFF_MISC + 786432 + 4096;
constexpr size_t OFF_H = OFF_MISC + 1048576;
constexpr size_t OFF_ARENA = OFF_H + 16384ull * 1024 * 2;
constexpr size_t OFF_Y = OFF_ARENA;
constexpr size_t OFF_HID = OFF_ARENA + 67108864ull;
constexpr size_t OFF_SI = OFF_ARENA;
constexpr size_t OFF_P = OFF_SI + 16384ull * 6 * 768;
constexpr size_t OFF_Q = OFF_P + 16384ull * 2336 * 2;
constexpr size_t OFF_KN = OFF_Q + 16384ull * 576 * 2;
constexpr size_t OFF_VT = OFF_KN + 16384ull * 384 * 2;
constexpr size_t OFF_KPE = OFF_VT + 16384ull * 384 * 2;
constexpr size_t OFF_YRAW = OFF_P;
static_assert(OFF_KPE + 16384ull * 32 * 2 <= 268435456ull, "ws");
static_assert(OFF_HID + 16384ull * 4096 * 2 <= 268435456ull, "ws");

struct Params {
  const float* x; const float* c; const int* pos;
  const float *g_pre_mix, *g_post_mix, *g_pre_ffn, *g_post_ffn, *w_ada, *b_ada, *w_in, *w_out;
  const float *mu, *w0, *w2, *a0, *a2, *g2, *k_k, *k_a, *r_k, *rln_w, *rln_b;
  const float *conv_w, *conv_b, *cln_w, *cln_b;
  const float *q_norm, *w_uq, *kv_norm, *w_ukv, *w_ff1, *w_ff2;
  float* out;
  char* ws;
};

DI bf16_t f2bf(float x) { unsigned u = __float_as_uint(x); u += 0x7fffu + ((u >> 16) & 1u); return (bf16_t)(u >> 16); }
DI float bf2f(bf16_t h) { return __uint_as_float(((unsigned)h) << 16); }
DI unsigned pack2(float a, float b) { return (unsigned)f2bf(a) | ((unsigned)f2bf(b) << 16); }
typedef __bf16 hwbf2 __attribute__((ext_vector_type(2)));
typedef float hwf2 __attribute__((ext_vector_type(2)));
DI unsigned pack2h(float a, float b) { hwf2 v = {a, b}; return __builtin_bit_cast(unsigned, __builtin_convertvector(v, hwbf2)); }
DI bf16_t f2bfh(float x) { return (bf16_t)(pack2h(x, x) & 0xffffu); }
DI float bflo(unsigned u) { return __uint_as_float(u << 16); }
DI float bfhi(unsigned u) { return __uint_as_float(u & 0xffff0000u); }

DI void fmac(float& acc, float a, float b) { asm("v_fmac_f32 %0, %1, %2" : "+v"(acc) : "v"(a), "v"(b)); }
DI float sigmoidf_(float x) { return __builtin_amdgcn_rcpf(1.f + __expf(-x)); }
template <int CTRL> DI float dppf(float x) {
  return __int_as_float(__builtin_amdgcn_update_dpp(0, __float_as_int(x), CTRL, 0xf, 0xf, true));
}
DI float allreduce16(float x) {
  x += dppf<0xB1>(x);
  x += dppf<0x4E>(x);
  x += dppf<0x141>(x);
  x += dppf<0x140>(x);
  return x;
}
DI float wave_sum(float v) {
  v = allreduce16(v);
  const int iv = __float_as_int(v);
  float s0 = __int_as_float(__builtin_amdgcn_readlane(iv, 0)), s1 = __int_as_float(__builtin_amdgcn_readlane(iv, 16));
  float s2 = __int_as_float(__builtin_amdgcn_readlane(iv, 32)), s3 = __int_as_float(__builtin_amdgcn_readlane(iv, 48));
  return (s0 + s1) + (s2 + s3);
}


#define XB_TMO      128
#define XB_XCNT(j)  (256  + 64 * (j))
#define XB_XSUB(j)  (1280 + 64 * (j))
#define XB_XGEN(j)  (2304 + 64 * (j))
#define XB_TOP      3328
#define XB_TOPGEN   3392
#define XCD_BAR_WORDS 3456
#define XB_SPIN_CAP (1u << 18)
#define LAS __attribute__((address_space(3)))
DI unsigned xb_ld(unsigned* p) { return __hip_atomic_load(p, __ATOMIC_RELAXED, __HIP_MEMORY_SCOPE_AGENT); }
DI unsigned xb_add(unsigned* p, unsigned v) { return __hip_atomic_fetch_add(p, v, __ATOMIC_RELAXED, __HIP_MEMORY_SCOPE_AGENT); }
DI unsigned xb_xcc_id() { return (unsigned)__builtin_amdgcn_s_getreg((3 << 11) | 20) & 0xFu; }
#define XB_SPIN(cond, bar) do { unsigned _sp = 0; while (cond) { __builtin_amdgcn_s_sleep(1); \
    if ((++_sp & 255u) == 0u) { if (xb_ld(&(bar)[XB_TMO])) break; if (_sp > XB_SPIN_CAP) { atomicAdd(&(bar)[XB_TMO], 1u); break; } } } } while (0)
struct XcdBarrier { unsigned* bar; unsigned x; volatile LAS unsigned* st; };
DI XcdBarrier xcd_barrier_post(unsigned* bar, volatile LAS unsigned* st) {
  XcdBarrier b; b.bar = bar; b.x = xb_xcc_id(); b.st = st;
  if (threadIdx.x == 0) (void)xb_add(&bar[XB_XCNT(b.x)], 1u);
  return b;
}
DI void xcd_barrier_complete(unsigned* bar, unsigned x, unsigned& nloc, unsigned& nx) {
  const unsigned G = gridDim.x * gridDim.y * gridDim.z;
  unsigned sum, cnt, mine, sp = 0u;
  for (;;) {
    sum = 0u; cnt = 0u; mine = 0u;
#pragma unroll
    for (unsigned j = 0; j < 16; ++j) { const unsigned c = xb_ld(&bar[XB_XCNT(j)]); sum += c; cnt += (c > 0u) ? 1u : 0u; mine = (j == x) ? c : mine; }
    if (sum == G) break;
    __builtin_amdgcn_s_sleep(1);
    if ((++sp & 255u) == 0u) { if (xb_ld(&bar[XB_TMO])) break; if (sp > XB_SPIN_CAP) { atomicAdd(&bar[XB_TMO], 1u); break; } }
  }
  nloc = mine > 0u ? mine : 1u; nx = cnt > 0u ? cnt : 1u;
}
DI void xcd_barrier(const XcdBarrier& b) {
  asm volatile("s_waitcnt vmcnt(0)" ::: "memory");
  __syncthreads();
  if (threadIdx.x == 0) {
    unsigned* bar = b.bar;
    __builtin_amdgcn_s_waitcnt(0);
    unsigned nloc = b.st[0], nx = b.st[1];
    if (nloc == 0u) { xcd_barrier_complete(bar, b.x, nloc, nx); b.st[0] = nloc; b.st[1] = nx; }
    const unsigned old = xb_add(&bar[XB_XSUB(b.x)], 1u);
    const unsigned gen = old / nloc;
    if (old + 1u == (gen + 1u) * nloc) {
      __builtin_amdgcn_fence(__ATOMIC_RELEASE, "agent");
      asm volatile("s_waitcnt vmcnt(0)" ::: "memory");
      const unsigned og = xb_add(&bar[XB_TOP], 1u);
      const unsigned tg = og / nx;
      if (og + 1u == (tg + 1u) * nx) xb_add(&bar[XB_TOPGEN], 1u);
      else XB_SPIN(xb_ld(&bar[XB_TOPGEN]) == tg, bar);
      __builtin_amdgcn_fence(__ATOMIC_ACQUIRE, "agent");
      xb_add(&bar[XB_XGEN(b.x)], 1u);
      asm volatile("s_waitcnt vmcnt(0)" ::: "memory");
    } else {
      XB_SPIN(xb_ld(&bar[XB_XGEN(b.x)]) == gen, bar);
      __builtin_amdgcn_fence(__ATOMIC_ACQUIRE, "agent");
      asm volatile("s_waitcnt vmcnt(0)" ::: "memory");
    }
  }
  __syncthreads();
}

DI void sub_barrier_wait(unsigned* ctr, unsigned n) {
  if (threadIdx.x == 0) {
    unsigned sp = 0;
    while (xb_ld(ctr) < n) { __builtin_amdgcn_s_sleep(2); if (++sp > (1u << 22)) break; }
    __builtin_amdgcn_fence(__ATOMIC_ACQUIRE, "agent");
    asm volatile("s_waitcnt vmcnt(0)" ::: "memory");
  }
  __syncthreads();
}
DI void sub_barrier(unsigned* ctr, unsigned n) {
  asm volatile("s_waitcnt vmcnt(0)" ::: "memory");
  __syncthreads();
  if (threadIdx.x == 0) {
    __builtin_amdgcn_fence(__ATOMIC_RELEASE, "agent");
    asm volatile("s_waitcnt vmcnt(0)" ::: "memory");
    (void)xb_add(ctr, 1u);
  }
  sub_barrier_wait(ctr, n);
}

DI void convert_tile(const float* __restrict__ W, int Kdim, int Ndim, bf16_t* __restrict__ Wt, int kt, int nt,
                     const float* __restrict__ kscale, char* smem) {
  float (*s)[65] = (float (*)[65])smem;
  const int tid = threadIdx.x;
#pragma unroll
  for (int i = 0; i < 16; ++i) {
    int idx = tid + 256 * i; int kk = idx >> 6, nn = idx & 63;
    int n = nt * 64 + nn, k = kt * 64 + kk;
    float v = (n < Ndim) ? W[(size_t)k * Ndim + n] : 0.f;
    if (kscale) v *= kscale[k];
    s[kk][nn] = v;
  }
  __syncthreads();
#pragma unroll 4
  for (int i = 0; i < 8; ++i) {
    int idx = tid + 256 * i; int nn = idx >> 5, kp = idx & 31;
    unsigned pk = pack2h(s[2 * kp][nn], s[2 * kp + 1][nn]);
    *(unsigned*)(Wt + (size_t)(nt * 64 + nn) * Kdim + kt * 64 + 2 * kp) = pk;
  }
  __syncthreads();
}

DI void convert_layer(const Params& P, int l, char* smem) {
  char* ws = P.ws;
  const int n_in = 16 * 38, n_out = 16 * 16, n_ff1 = 16 * 64, n_ff2 = 64 * 16, n_uq = 4 * 10, n_ukv = 4 * 12;
  const int total = n_in + n_out + n_ff1 + n_ff2 + n_uq + n_ukv;
  for (int it = blockIdx.x; it < 6; it += gridDim.x) {
    bf16_t* lo = (bf16_t*)(ws + OFF_LORA) + it * 8192;
    for (int i = 0; i < 32; ++i) {
      int e = threadIdx.x + 256 * i; int n = e >> 7, k = e & 127; int cg_ = it * 64 + n;
      float v = (k < 32) ? P.w2[((size_t)l * 32 + k) * 384 + cg_] : (k < 64) ? P.a2[((size_t)l * 32 + (k - 32)) * 384 + cg_] : P.g2[((size_t)l * 64 + (k - 64)) * 384 + cg_];
      lo[e] = f2bf(v);
    }
  }
  for (int it = blockIdx.x; it < total; it += gridDim.x) {
    int i = it;
    if (i < n_in) { convert_tile(P.w_in + (size_t)l * 1024 * 2336, 1024, 2336, (bf16_t*)(ws + OFF_WIN), i % 16, i / 16, nullptr, smem); continue; }
    i -= n_in;
    if (i < n_out) { convert_tile(P.w_out + (size_t)l * 1024 * 1024, 1024, 1024, (bf16_t*)(ws + OFF_WOUT), i % 16, i / 16, nullptr, smem); continue; }
    i -= n_out;
    if (i < n_ff1) { convert_tile(P.w_ff1 + (size_t)l * 1024 * 4096, 1024, 4096, (bf16_t*)(ws + OFF_WFF1), i % 16, i / 16, nullptr, smem); continue; }
    i -= n_ff1;
    if (i < n_ff2) { convert_tile(P.w_ff2 + (size_t)l * 4096 * 1024, 4096, 1024, (bf16_t*)(ws + OFF_WFF2), i % 64, i / 64, nullptr, smem); continue; }
    i -= n_ff2;
    if (i < n_uq) { convert_tile(P.w_uq + (size_t)l * 256 * 576, 256, 576, (bf16_t*)(ws + OFF_WUQ), i % 4, i / 4, P.q_norm + l * 256, smem); continue; }
    i -= n_uq;
    convert_tile(P.w_ukv + (size_t)l * 256 * 768, 256, 768, (bf16_t*)(ws + OFF_WUKV), i % 4, i / 4, P.kv_norm + l * 256, smem);
  }
}

DI void mod_items(const Params& P, char* smem) {
  float* cs = (float*)smem;
  float* red = cs + 4096;
  float* mod = (float*)(P.ws + OFF_MOD);
  const int tid = threadIdx.x;
  for (int it = blockIdx.x; it < 192; it += gridDim.x) {
    int l = it / 96, nc = it % 96;
    __syncthreads();
    for (int i = 0; i < 16; ++i) { int idx = tid + 256 * i; float v = P.c[idx]; cs[idx] = v * sigmoidf_(v); }
    __syncthreads();
    int kg = tid >> 6, cn = tid & 63, n = nc * 64 + cn;
    const float* wp = P.w_ada + (size_t)l * 1024 * 6144 + n;
    float a0 = 0, a1 = 0, a2 = 0, a3 = 0;
#pragma unroll 16
    for (int k = kg * 256; k < kg * 256 + 256; ++k) {
      float w = wp[(size_t)k * 6144];
      a0 += cs[k] * w; a1 += cs[1024 + k] * w; a2 += cs[2048 + k] * w; a3 += cs[3072 + k] * w;
    }
    red[(kg * 4 + 0) * 64 + cn] = a0; red[(kg * 4 + 1) * 64 + cn] = a1; red[(kg * 4 + 2) * 64 + cn] = a2; red[(kg * 4 + 3) * 64 + cn] = a3;
    __syncthreads();
    {
      int b = tid >> 6;
      float s = red[(0 * 4 + b) * 64 + cn] + red[(1 * 4 + b) * 64 + cn] + red[(2 * 4 + b) * 64 + cn] + red[(3 * 4 + b) * 64 + cn];
      mod[(size_t)(l * 4 + b) * 6144 + n] = s + P.b_ada[l * 6144 + n];
    }
  }
}

DI void row_pass(const float* xsrc, const bf16_t* __restrict__ y, const float* __restrict__ gate,
                 const float* __restrict__ g_post, float* xdst, const float* __restrict__ g_pre,
                 const float* __restrict__ sc, const float* __restrict__ sh, bf16_t* __restrict__ hdst) {
  const int lane = threadIdx.x & 63, w = threadIdx.x >> 6;
  for (int row0 = (blockIdx.x * 4 + w) * 2; row0 < 16384; row0 += gridDim.x * 8) {
    const int b = row0 >> 12;
    float4 xv[2][4], yv[2][4];
#pragma unroll
    for (int r = 0; r < 2; ++r)
#pragma unroll
      for (int i = 0; i < 4; ++i) {
        xv[r][i] = *(const float4*)(xsrc + (size_t)(row0 + r) * 1024 + lane * 4 + 256 * i);
        if (y) {
          const uint2 yb = *(const uint2*)(y + (size_t)(row0 + r) * 1024 + lane * 4 + 256 * i);
          yv[r][i] = float4{bflo(yb.x), bfhi(yb.x), bflo(yb.y), bfhi(yb.y)};
        }
      }
    if (y) {
      float ss[2];
#pragma unroll
      for (int r = 0; r < 2; ++r) {
        float s = 0;
#pragma unroll
        for (int i = 0; i < 4; ++i) s += yv[r][i].x * yv[r][i].x + yv[r][i].y * yv[r][i].y + yv[r][i].z * yv[r][i].z + yv[r][i].w * yv[r][i].w;
        ss[r] = s;
      }
      ss[0] = wave_sum(ss[0]); ss[1] = wave_sum(ss[1]);
#pragma unroll
      for (int i = 0; i < 4; ++i) {
        int col = lane * 4 + 256 * i;
        float4 g = *(const float4*)(g_post + col);
        float4 gt = *(const float4*)(gate + (size_t)b * 6144 + col);
#pragma unroll
        for (int r = 0; r < 2; ++r) {
          float rstd = rsqrtf(ss[r] * (1.f / 1024.f) + 1e-6f);
          xv[r][i].x += gt.x * (yv[r][i].x * rstd * g.x); xv[r][i].y += gt.y * (yv[r][i].y * rstd * g.y);
          xv[r][i].z += gt.z * (yv[r][i].z * rstd * g.z); xv[r][i].w += gt.w * (yv[r][i].w * rstd * g.w);
        }
      }
    }
    if (xdst) {
#pragma unroll
      for (int r = 0; r < 2; ++r)
#pragma unroll
        for (int i = 0; i < 4; ++i) *(float4*)(xdst + (size_t)(row0 + r) * 1024 + lane * 4 + 256 * i) = xv[r][i];
    }
    if (hdst) {
      float ss[2];
#pragma unroll
      for (int r = 0; r < 2; ++r) {
        float s = 0;
#pragma unroll
        for (int i = 0; i < 4; ++i) s += xv[r][i].x * xv[r][i].x + xv[r][i].y * xv[r][i].y + xv[r][i].z * xv[r][i].z + xv[r][i].w * xv[r][i].w;
        ss[r] = s;
      }
      ss[0] = wave_sum(ss[0]); ss[1] = wave_sum(ss[1]);
#pragma unroll
      for (int i = 0; i < 4; ++i) {
        int col = lane * 4 + 256 * i;
        float4 g = *(const float4*)(g_pre + col);
        float4 s1 = *(const float4*)(sc + (size_t)b * 6144 + col);
        float4 s0 = *(const float4*)(sh + (size_t)b * 6144 + col);
#pragma unroll
        for (int r = 0; r < 2; ++r) {
          float rstd = rsqrtf(ss[r] * (1.f / 1024.f) + 1e-6f);
          float h0 = xv[r][i].x * rstd * g.x * (1.f + s1.x) + s0.x;
          float h1 = xv[r][i].y * rstd * g.y * (1.f + s1.y) + s0.y;
          float h2 = xv[r][i].z * rstd * g.z * (1.f + s1.z) + s0.z;
          float h3 = xv[r][i].w * rstd * g.w * (1.f + s1.w) + s0.w;
          uint2 o; o.x = pack2h(h0, h1); o.y = pack2h(h2, h3);
          *(uint2*)(hdst + (size_t)(row0 + r) * 1024 + col) = o;
        }
      }
    }
  }
}

enum { EPI_P = 0, EPI_Q = 1, EPI_KV = 2, EPI_Y = 3, EPI_FF1 = 4 };

template <int EPI>
DI void gemm_tile(const bf16_t* __restrict__ A, int lda, const bf16_t* __restrict__ Bt, int K, int m0, int n0,
                  char* smem, void* out0, void* out1) {
  bf16_t* As = (bf16_t*)smem;
  bf16_t* Bs = As + 2 * 128 * 64;
  float* rs = (float*)(smem + 73728);
  const int tid = threadIdx.x, lane = tid & 63, w = tid >> 6, wm = w >> 1, wn = w & 1, qi = lane & 15, quad = lane >> 4;
  __syncthreads();
  if (EPI == EPI_Q || EPI == EPI_KV) {
    int row = tid >> 1, half = tid & 1;
    const uint4* src = (const uint4*)(A + (size_t)(m0 + row) * lda + half * 128);
    float ss = 0;
#pragma unroll
    for (int i = 0; i < 16; ++i) {
      uint4 v = src[i];
      float f;
      f = bflo(v.x); ss += f * f; f = bfhi(v.x); ss += f * f;
      f = bflo(v.y); ss += f * f; f = bfhi(v.y); ss += f * f;
      f = bflo(v.z); ss += f * f; f = bfhi(v.z); ss += f * f;
      f = bflo(v.w); ss += f * f; f = bfhi(v.w); ss += f * f;
    }
    ss += __shfl_xor(ss, 1);
    if (half == 0) rs[row] = rsqrtf(ss * (1.f / 256.f) + 1e-6f);
  }
  f32x4 acc[4][4];
#pragma unroll
  for (int i = 0; i < 4; ++i)
#pragma unroll
    for (int j = 0; j < 4; ++j) acc[i][j] = f32x4{0.f, 0.f, 0.f, 0.f};
  uint4 p0, p1, p2, p3, p4, p5, p6, p7;
  uint4 q0, q1, q2, q3, q4, q5, q6, q7;
  const int KT = K >> 6;
  const int lrow = tid >> 3, lcc = tid & 7;
  const bf16_t* Ap = A + (size_t)(m0 + lrow) * lda + lcc * 8;
  const bf16_t* Bp = Bt + (size_t)(n0 + lrow) * K + lcc * 8;
  const int wpos = (lcc ^ ((lrow >> 1) & 7)) * 8;
  bf16_t* Aw = As + lrow * 64 + wpos;
  bf16_t* Bw = Bs + lrow * 64 + wpos;
  const int rp0 = (quad ^ ((qi >> 1) & 7)) * 8, rp1 = rp0 ^ 32;
#define GLOAD(kt, R0, R1, R2, R3, R4, R5, R6, R7)                        \
  {                                                                      \
    R0 = *(const uint4*)(Ap + (size_t)(0) * lda + (kt) * 64);            \
    R1 = *(const uint4*)(Ap + (size_t)(32) * lda + (kt) * 64);           \
    R2 = *(const uint4*)(Ap + (size_t)(64) * lda + (kt) * 64);           \
    R3 = *(const uint4*)(Ap + (size_t)(96) * lda + (kt) * 64);           \
    R4 = *(const uint4*)(Bp + (size_t)(0) * K + (kt) * 64);              \
    R5 = *(const uint4*)(Bp + (size_t)(32) * K + (kt) * 64);             \
    R6 = *(const uint4*)(Bp + (size_t)(64) * K + (kt) * 64);             \
    R7 = *(const uint4*)(Bp + (size_t)(96) * K + (kt) * 64);             \
  }
#define SWRITE(buf, R0, R1, R2, R3, R4, R5, R6, R7)                      \
  {                                                                      \
    *(uint4*)(Aw + ((buf) * 128 + 0) * 64) = R0;                         \
    *(uint4*)(Aw + ((buf) * 128 + 32) * 64) = R1;                        \
    *(uint4*)(Aw + ((buf) * 128 + 64) * 64) = R2;                        \
    *(uint4*)(Aw + ((buf) * 128 + 96) * 64) = R3;                        \
    *(uint4*)(Bw + ((buf) * 128 + 0) * 64) = R4;                         \
    *(uint4*)(Bw + ((buf) * 128 + 32) * 64) = R5;                        \
    *(uint4*)(Bw + ((buf) * 128 + 64) * 64) = R6;                        \
    *(uint4*)(Bw + ((buf) * 128 + 96) * 64) = R7;                        \
  }
#define GLOAD0(kt) GLOAD(kt, p0, p1, p2, p3, p4, p5, p6, p7)
#define GLOAD1(kt) GLOAD(kt, q0, q1, q2, q3, q4, q5, q6, q7)
#define SWRITE0(buf) SWRITE(buf, p0, p1, p2, p3, p4, p5, p6, p7)
#define SWRITE1(buf) SWRITE(buf, q0, q1, q2, q3, q4, q5, q6, q7)
#define LBAR { asm volatile("s_waitcnt lgkmcnt(0)" ::: "memory"); __builtin_amdgcn_s_barrier(); }
#define FRAGS(buf)                                                                                        \
  {                                                                                                       \
    const bf16_t* as = As + (buf) * 128 * 64 + (wm * 64 + qi) * 64;                                       \
    const bf16_t* bs = Bs + (buf) * 128 * 64 + (wn * 64 + qi) * 64;                                       \
    _Pragma("unroll") for (int i = 0; i < 4; ++i) {                                                       \
      af0[i] = *(const bf16x8*)(as + i * 16 * 64 + rp0);                                                  \
      bf0[i] = *(const bf16x8*)(bs + i * 16 * 64 + rp0);                                                  \
    }                                                                                                     \
    _Pragma("unroll") for (int i = 0; i < 4; ++i) af1[i] = *(const bf16x8*)(as + i * 16 * 64 + rp1);      \
    bf1[0] = *(const bf16x8*)(bs + 0 * 16 * 64 + rp1);                                                    \
    bf1[1] = *(const bf16x8*)(bs + 1 * 16 * 64 + rp1);                                                    \
  }
#define MMA(buf, SWR)                                                                                     \
  {                                                                                                       \
    __builtin_amdgcn_s_setprio(1);                                                                        \
    _Pragma("unroll") for (int mt = 0; mt < 4; ++mt)                                                      \
      _Pragma("unroll") for (int nt = 0; nt < 4; ++nt)                                                    \
        acc[mt][nt] = __builtin_amdgcn_mfma_f32_16x16x32_bf16(bf0[nt], af0[mt], acc[mt][nt], 0, 0, 0);    \
    __builtin_amdgcn_sched_barrier(0);                                                                    \
    SWR;                                                                                                  \
    {                                                                                                     \
      const bf16_t* bs = Bs + (buf) * 128 * 64 + (wn * 64 + qi) * 64;                                     \
      bf1[2] = *(const bf16x8*)(bs + 2 * 16 * 64 + rp1);                                                  \
      bf1[3] = *(const bf16x8*)(bs + 3 * 16 * 64 + rp1);                                                  \
    }                                                                                                     \
    _Pragma("unroll") for (int nt = 0; nt < 4; ++nt)                                                      \
      _Pragma("unroll") for (int mt = 0; mt < 4; ++mt)                                                    \
        acc[mt][nt] = __builtin_amdgcn_mfma_f32_16x16x32_bf16(bf1[nt], af1[mt], acc[mt][nt], 0, 0, 0);    \
    __builtin_amdgcn_s_setprio(0);                                                                        \
  }
  bf16x8 af0[4], bf0[4], af1[4], bf1[4];
  GLOAD0(0);
  GLOAD1(1);
  SWRITE0(0);
  LBAR;
  for (int kt = 0; kt < KT; kt += 2) {
    const int k2 = (kt + 2 < KT) ? kt + 2 : KT - 2, k3 = (kt + 3 < KT) ? kt + 3 : KT - 1;
    GLOAD0(k2);
    __builtin_amdgcn_sched_barrier(0);
    FRAGS(0);
    __builtin_amdgcn_sched_barrier(0);
    MMA(0, SWRITE1(1));
    LBAR;
    GLOAD1(k3);
    __builtin_amdgcn_sched_barrier(0);
    FRAGS(1);
    __builtin_amdgcn_sched_barrier(0);
    MMA(1, SWRITE0(0));
    LBAR;
  }
#undef FRAGS
#undef MMA
#undef GLOAD0
#undef GLOAD1
#undef SWRITE0
#undef SWRITE1
#undef GLOAD
#undef SWRITE
#undef LBAR
  if (EPI == EPI_P || EPI == EPI_FF1 || EPI == EPI_Y) {
    bf16_t* Cs = (bf16_t*)smem;
#pragma unroll
    for (int mt = 0; mt < 4; ++mt) {
      const int ml = wm * 64 + mt * 16 + qi;
#pragma unroll
      for (int nt = 0; nt < 4; ++nt) {
        const int nl = wn * 64 + nt * 16 + quad * 4;
        f32x4 v = acc[mt][nt];
        if (EPI == EPI_FF1) {
          float a = fmaxf(v[0], 0.f), b = fmaxf(v[1], 0.f), c = fmaxf(v[2], 0.f), d = fmaxf(v[3], 0.f);
          v[0] = a * a; v[1] = b * b; v[2] = c * c; v[3] = d * d;
        }
        uint2 o; o.x = pack2h(v[0], v[1]); o.y = pack2h(v[2], v[3]);
        *(uint2*)(Cs + ml * 136 + nl) = o;
      }
    }
    asm volatile("s_waitcnt lgkmcnt(0)" ::: "memory");
    __builtin_amdgcn_s_barrier();
    const int ldo = (EPI == EPI_P) ? 2336 : (EPI == EPI_Y) ? 1024 : 4096;
#pragma unroll
    for (int i = 0; i < 8; ++i) {
      const int id = tid + 256 * i, row = id >> 4, cc = (id & 15) * 8;
      uint4 d = *(const uint4*)(Cs + row * 136 + cc);
      if (EPI != EPI_P || n0 + cc < 2336) *(uint4*)((bf16_t*)out0 + (size_t)(m0 + row) * ldo + n0 + cc) = d;
    }
    return;
  }
  if (false) {
    float* Cf = (float*)smem;
#pragma unroll
    for (int mt = 0; mt < 4; ++mt) {
      const int ml = wm * 64 + mt * 16 + qi;
#pragma unroll
      for (int nt = 0; nt < 4; ++nt) {
        const int nl = wn * 64 + nt * 16 + quad * 4;
        f32x4 v = acc[mt][nt];
        *(float4*)(Cf + ml * 132 + nl) = float4{v[0], v[1], v[2], v[3]};
      }
    }
    asm volatile("s_waitcnt lgkmcnt(0)" ::: "memory");
    __builtin_amdgcn_s_barrier();
#pragma unroll
    for (int i = 0; i < 16; ++i) {
      const int id = tid + 256 * i, row = id >> 5, cc = (id & 31) * 4;
      float4 d = *(const float4*)(Cf + row * 132 + cc);
      *(float4*)((float*)out0 + (size_t)(m0 + row) * 1024 + n0 + cc) = d;
    }
    return;
  }
#pragma unroll
  for (int mt = 0; mt < 4; ++mt) {
    const int ml = wm * 64 + mt * 16 + qi;
    const int m = m0 + ml;
    float r = 1.f;
    if (EPI == EPI_Q || EPI == EPI_KV) r = rs[ml];
#pragma unroll
    for (int nt = 0; nt < 4; ++nt) {
      const int nl = wn * 64 + nt * 16 + quad * 4;
      const int n = n0 + nl;
      f32x4 v = acc[mt][nt];
      if (EPI == EPI_P) {
        if (n < 2336) { uint2 o; o.x = pack2(v[0], v[1]); o.y = pack2(v[2], v[3]); *(uint2*)((bf16_t*)out0 + (size_t)m * 2336 + n) = o; }
      } else if (EPI == EPI_Y) {
        *(float4*)((float*)out0 + (size_t)m * 1024 + n) = float4{v[0], v[1], v[2], v[3]};
      } else if (EPI == EPI_FF1) {
        float a = fmaxf(v[0], 0.f), b = fmaxf(v[1], 0.f), c = fmaxf(v[2], 0.f), d = fmaxf(v[3], 0.f);
        uint2 o; o.x = pack2(a * a, b * b); o.y = pack2(c * c, d * d);
        *(uint2*)((bf16_t*)out0 + (size_t)m * 4096 + n) = o;
      } else if (EPI == EPI_Q) {
        if (n < 576) { uint2 o; o.x = pack2(v[0] * r, v[1] * r); o.y = pack2(v[2] * r, v[3] * r); *(uint2*)((bf16_t*)out0 + (size_t)m * 576 + n) = o; }
      } else if (EPI == EPI_KV) {
        const int h = n0 >> 7, b = m >> 12, t = m & 4095;
        if (nl < 64) {
          uint2 o; o.x = pack2(v[0] * r, v[1] * r); o.y = pack2(v[2] * r, v[3] * r);
          *(uint2*)((bf16_t*)out0 + ((size_t)(b * 6 + h) * 4096 + t) * 64 + nl) = o;
        } else {
          bf16_t* vt = (bf16_t*)out1 + ((size_t)(b * 6 + h) * 64 + (nl - 64)) * 4096 + t;
          vt[0] = f2bf(v[0] * r); vt[4096] = f2bf(v[1] * r); vt[8192] = f2bf(v[2] * r); vt[12288] = f2bf(v[3] * r);
        }
      }
    }
  }
}

template <int EPI>
DI void gemm_phase(const bf16_t* A, int lda, const bf16_t* Bt, int K, int NT, char* smem, void* out0, void* out1) {
  if ((NT & 7) == 0 && gridDim.x == 512) {
    const int xcd = blockIdx.x & 7, j = blockIdx.x >> 3;
    const int nsc = NT >> 3, nsuper = 16 * nsc;
    for (int s = xcd; s < nsuper; s += 8) {
      int sm = s / nsc, sn = s - sm * nsc;
      gemm_tile<EPI>(A, lda, Bt, K, (sm * 8 + (j >> 3)) * 128, (sn * 8 + (j & 7)) * 128, smem, out0, out1);
    }
    return;
  }
  if (gridDim.x == 512) {
    const int xcd = blockIdx.x & 7, j = blockIdx.x >> 3;
    for (int idx = j; idx < 16 * NT; idx += 64) {
      int ml = idx / NT, nt = idx - ml * NT;
      gemm_tile<EPI>(A, lda, Bt, K, (xcd * 16 + ml) * 128, nt * 128, smem, out0, out1);
    }
    return;
  }
  const int total = 128 * NT;
  for (int it = blockIdx.x; it < total; it += gridDim.x) {
    int mt = it / NT, nt = it % NT;
    gemm_tile<EPI>(A, lda, Bt, K, mt * 128, nt * 128, smem, out0, out1);
  }
}

DI float ld_shift(const bf16_t* p, size_t m, int t, int col, float mu) {
  const size_t mp = m - (size_t)(t > 0 ? 1 : 0);
  const bf16_t c16 = p[m * 2336 + col], p16 = p[mp * 2336 + col];
  float cur = bf2f(c16);
  float prev = bf2f(p16);
  prev = (t > 0) ? prev : 0.f;
  return cur + (prev - cur) * mu;
}

DI void prep_rwkv_item(const Params& P, int l, int item, char* smem) {
  bf16_t* ZA = (bf16_t*)smem;
  bf16_t* WB = (bf16_t*)(smem + 17408);
  float* ACC = (float*)smem;
  const bf16_t* p = (const bf16_t*)(P.ws + OFF_P);
  bf16_t* SI = (bf16_t*)(P.ws + OFF_SI);
  bf16_t* ycat = (bf16_t*)(P.ws + OFF_H);
  float* bonus = (float*)(P.ws + OFF_BONUS);
  const int tid = threadIdx.x;
  const int h = item % 6, tt = (item / 6) & 63, b = item / 384;
  const int t0 = tt * 64;
  const float* mu = P.mu + l * 1280;
  __syncthreads();
  {
    const bf16_t* lo = (const bf16_t*)(P.ws + OFF_LORA) + h * 8192;
#pragma unroll
    for (int i = 0; i < 4; ++i) {
      int id = tid + 256 * i; int n = id >> 4, kc = (id & 15) * 8;
      *(uint4*)(WB + n * 136 + kc) = *(const uint4*)(lo + n * 128 + kc);
    }
  }
  const float mu_lo = mu[1152 + (tid & 127)];
#pragma unroll 16
  for (int i = 0; i < 32; ++i) {
    int idx = tid + 256 * i; int tok = idx >> 7, j = idx & 127;
    int t = t0 + tok; size_t m = (size_t)b * 4096 + t;
    float z = ld_shift(p, m, t, 1152 + j, mu_lo);
    const float sg_ = sigmoidf_((j < 32) ? 2.f * z : z);
    z = (j < 32) ? (2.f * sg_ - 1.f) : ((j >= 64) ? sg_ : z);
    ZA[tok * 136 + j] = f2bfh(z);
  }
  __syncthreads();
  const int g = tid >> 6, c = tid & 63, col = h * 64 + c;
  {
    const int qi = c & 15, quad = c >> 4;
    bf16x8 af[4];
#pragma unroll
    for (int ks = 0; ks < 4; ++ks) af[ks] = *(const bf16x8*)(ZA + (g * 16 + qi) * 136 + ks * 32 + quad * 8);
    f32x4 cw[4], ca[4], cg2[4];
#pragma unroll
    for (int nt = 0; nt < 4; ++nt) {
      const bf16_t* wb = WB + (nt * 16 + qi) * 136 + quad * 8;
      bf16x8 b0 = *(const bf16x8*)(wb), b1 = *(const bf16x8*)(wb + 32), b2 = *(const bf16x8*)(wb + 64), b3 = *(const bf16x8*)(wb + 96);
      const f32x4 z4 = {0.f, 0.f, 0.f, 0.f};
      cw[nt] = __builtin_amdgcn_mfma_f32_16x16x32_bf16(af[0], b0, z4, 0, 0, 0);
      ca[nt] = __builtin_amdgcn_mfma_f32_16x16x32_bf16(af[1], b1, z4, 0, 0, 0);
      cg2[nt] = __builtin_amdgcn_mfma_f32_16x16x32_bf16(af[2], b2, z4, 0, 0, 0);
      cg2[nt] = __builtin_amdgcn_mfma_f32_16x16x32_bf16(af[3], b3, cg2[nt], 0, 0, 0);
    }
    __syncthreads();
#pragma unroll
    for (int nt = 0; nt < 4; ++nt)
#pragma unroll
      for (int j = 0; j < 4; ++j) {
        const int o = (g * 16 + quad * 4 + j) * 68 + nt * 16 + qi;
        ACC[o] = cw[nt][j]; ACC[64 * 68 + o] = ca[nt][j]; ACC[2 * 64 * 68 + o] = cg2[nt][j];
      }
    asm volatile("s_waitcnt lgkmcnt(0)" ::: "memory");
  }
  const float w0 = P.w0[l * 384 + col], a0 = P.a0[l * 384 + col], kkw = P.k_k[l * 384 + col], kaw = P.k_a[l * 384 + col];
  const float rkw = P.r_k[l * 384 + col];
  const float mu_r = mu[col], mu_k = mu[384 + col], mu_v = mu[768 + col];
#pragma unroll 1
  for (int sub = 0; sub < 4; ++sub) {
    float accw[4], acca[4], accg[4];
    float rsh[4], ksh[4], vsh[4];
#pragma unroll
    for (int i = 0; i < 4; ++i) {
      int t = t0 + g * 16 + sub * 4 + i; size_t m = (size_t)b * 4096 + t;
      rsh[i] = ld_shift(p, m, t, col, mu_r);
      ksh[i] = ld_shift(p, m, t, 384 + col, mu_k);
      vsh[i] = ld_shift(p, m, t, 768 + col, mu_v);
      const int o = (g * 16 + sub * 4 + i) * 68 + c;
      accw[i] = ACC[o]; acca[i] = ACC[64 * 68 + o]; accg[i] = ACC[2 * 64 * 68 + o];
    }
    bf16_t* stg = (bf16_t*)(smem + 52224) + g * 896;
#pragma unroll
    for (int pr = 0; pr < 2; ++pr) {
      float bonv[2];
#pragma unroll
      for (int tk = 0; tk < 2; ++tk) {
        const int i = pr * 2 + tk;
        int t = t0 + g * 16 + sub * 4 + i; size_t m = (size_t)b * 4096 + t;
        float r = rsh[i], k = ksh[i], v = vsh[i];
        float xw = -(w0 + accw[i]);
        float sp = fmaxf(xw, 0.f) + __logf(1.f + __expf(-fabsf(xw)));
        float wl_ = -sp - 0.5f;
        float delta = 1.f - __expf(-__expf(wl_));
        float a = sigmoidf_(a0 + acca[i]);
        float kk = k * kkw;
        float ss = wave_sum(kk * kk);
        kk *= rsqrtf(fmaxf(ss, 1e-24f));
        float k2 = k * (1.f + (a - 1.f) * kaw);
        float bon = wave_sum(r * k2 * rkw);
        bf16_t* sg = stg + tk * 448 + c;
        sg[0] = f2bfh(delta); sg[64] = f2bfh(k2); sg[128] = f2bfh(-kk); sg[192] = f2bfh(kk * a); sg[256] = f2bfh(r); sg[320] = f2bfh(v);
        sg[384] = f2bfh(accg[i]);
        bonv[tk] = bon;
      }
      asm volatile("s_waitcnt lgkmcnt(0)" ::: "memory");
#pragma unroll
      for (int tk = 0; tk < 2; ++tk) {
        const int i = pr * 2 + tk;
        int t = t0 + g * 16 + sub * 4 + i; size_t m = (size_t)b * 4096 + t;
        if (c < 56) {
          uint4 d = *(const uint4*)(stg + tk * 448 + c * 8);
          bf16_t* dst = (c < 48) ? (SI + ((size_t)(b * 6 + h) * 4096 + t) * 384 + c * 8) : (ycat + m * 1024 + h * 64 + (c - 48) * 8);
          *(uint4*)dst = d;
        }
        if (c == 56) bonus[m * 6 + h] = bonv[tk];
      }
      asm volatile("s_waitcnt lgkmcnt(0)" ::: "memory");
    }
  }
}

DI void prep_conv_item(const Params& P, int l, int item, char* smem) {
  float* cv = (float*)smem;
  const bf16_t* p = (const bf16_t*)(P.ws + OFF_P);
  bf16_t* ycat = (bf16_t*)(P.ws + OFF_H);
  const int tid = threadIdx.x;
  const int b = item >> 7, t0 = (item & 127) * 32;
  __syncthreads();
  {
    const int c = tid;
    float hw[62];
#pragma unroll
    for (int j = 0; j < 62; ++j) {
      int t = t0 - 30 + j;
      const int tc = t < 0 ? 0 : t;
      size_t m = (size_t)b * 4096 + tc;
      float u = bf2f(p[m * 2336 + 1280 + c]);
      float gt = bf2f(p[m * 2336 + 1536 + c]);
      float hv = u * sigmoidf_(gt);
      hw[j] = (t >= 0) ? hv : 0.f;
    }
    float wj[31];
#pragma unroll
    for (int j = 0; j < 31; ++j) wj[j] = P.conv_w[(size_t)l * 31 * 256 + j * 256 + c];
    const float bias = P.conv_b[l * 256 + c];
#pragma unroll
    for (int i = 0; i < 32; ++i) {
      float o = bias;
#pragma unroll
      for (int j = 0; j < 31; ++j) fmac(o, hw[i + j], wj[j]);
      cv[i * 256 + c] = o;
    }
  }
  __syncthreads();
  const int w = tid >> 6, lane = tid & 63;
  float lnw[4], lnb[4];
#pragma unroll
  for (int q = 0; q < 4; ++q) { lnw[q] = P.cln_w[l * 256 + lane + 64 * q]; lnb[q] = P.cln_b[l * 256 + lane + 64 * q]; }
  for (int i = 0; i < 8; ++i) {
    int tok = w * 8 + i;
    float v[4]; float s = 0;
#pragma unroll
    for (int q = 0; q < 4; ++q) { v[q] = cv[tok * 256 + lane + 64 * q]; s += v[q]; }
    float mean = wave_sum(s) * (1.f / 256.f);
    float s2 = 0;
#pragma unroll
    for (int q = 0; q < 4; ++q) { float d = v[q] - mean; s2 += d * d; }
    float rstd = rsqrtf(wave_sum(s2) * (1.f / 256.f) + 1e-5f);
    size_t m = (size_t)b * 4096 + t0 + tok;
#pragma unroll
    for (int q = 0; q < 4; ++q) {
      int c = lane + 64 * q;
      float yv = (v[q] - mean) * rstd * lnw[q] + lnb[q];
      ycat[m * 1024 + 384 + c] = f2bf(yv * sigmoidf_(yv));
    }
  }
}

DI float rope_inv_freq(int i) { return exp2f(-(float)i * (13.287712379549449f / 16.f)); }
DI void fast_sincos(float ang, float& s, float& c) {
  float n = rintf(ang * 0.15915494309189535f);
  float r = fmaf(-n, 6.2831855f, ang);
  r = fmaf(-n, -1.7484555e-7f, r);
  s = __sinf(r); c = __cosf(r);
}

DI void prep_kpe_item(const Params& P, int item) {
  const bf16_t* p = (const bf16_t*)(P.ws + OFF_P);
  bf16_t* kpe = (bf16_t*)(P.ws + OFF_KPE);
  const int tid = threadIdx.x;
#pragma unroll 8
  for (int i = 0; i < 16; ++i) {
    int idx = tid + 256 * i;
    size_t m = (size_t)item * 256 + (idx >> 4); int fi = idx & 15;
    float x1 = bf2f(p[m * 2336 + 2304 + fi]), x2 = bf2f(p[m * 2336 + 2320 + fi]);
    float ang = (float)P.pos[m] * rope_inv_freq(fi);
    float cs, sn; fast_sincos(ang, sn, cs);
    kpe[m * 32 + fi] = f2bf(x1 * cs - x2 * sn);
    kpe[m * 32 + 16 + fi] = f2bf(x2 * cs + x1 * sn);
  }
}

constexpr int SCAN_BUF = 16 * 5 * 64 + 256;

DI void scan_chunk(const float* bb, const float* vb, int kq, float& S0, float& S1, float& S2, float& S3, float& ykeep) {
  float4 decA, kvA, avA, bvA, rvA, decB, kvB, avB, bvB, rvB, decC, kvC, avC, bvC, rvC;
  float vvA, vvB, vvC;
  float4 rprev = {0.f, 0.f, 0.f, 0.f};
#define LDSTEP(X, s)                                                                                      \
  {                                                                                                       \
    const float* bn = bb + (s) * 320;                                                                     \
    dec##X = *(const float4*)(bn + 0 * 64); kv##X = *(const float4*)(bn + 1 * 64);                        \
    av##X = *(const float4*)(bn + 2 * 64); bv##X = *(const float4*)(bn + 3 * 64);                         \
    rv##X = *(const float4*)(bn + 4 * 64); vv##X = vb[(s) * 16];                                          \
  }
#define STEP(s, X, PF)                                                                                    \
  {                                                                                                       \
    if ((s) + 2 < 16) LDSTEP(PF, (s) + 2)                                                                 \
    float sa, yv, t0, t1, t2, t3;                                                                         \
    asm volatile(                                                                                         \
        "v_mul_f32 %4, %0, %10\n\t"                                                                       \
        "v_mul_f32 %5, %0, %26\n\t"                                                                       \
        "v_fmac_f32 %4, %1, %11\n\t"                                                                      \
        "v_fmac_f32 %5, %1, %27\n\t"                                                                      \
        "v_fmac_f32 %4, %2, %12\n\t"                                                                      \
        "v_fmac_f32 %5, %2, %28\n\t"                                                                      \
        "v_fmac_f32 %4, %3, %13\n\t"                                                                      \
        "v_fmac_f32 %5, %3, %29\n\t"                                                                      \
        "v_mul_f32 %6, %0, %14\n\t"                                                                       \
        "v_mul_f32 %7, %1, %15\n\t"                                                                       \
        "v_add_f32_dpp %4, %4, %4 quad_perm:[1,0,3,2] row_mask:0xf bank_mask:0xf bound_ctrl:1\n\t"        \
        "v_add_f32_dpp %5, %5, %5 quad_perm:[1,0,3,2] row_mask:0xf bank_mask:0xf bound_ctrl:1\n\t"        \
        "v_mul_f32 %8, %2, %16\n\t"                                                                       \
        "v_add_f32_dpp %4, %4, %4 quad_perm:[2,3,0,1] row_mask:0xf bank_mask:0xf bound_ctrl:1\n\t"        \
        "v_add_f32_dpp %5, %5, %5 quad_perm:[2,3,0,1] row_mask:0xf bank_mask:0xf bound_ctrl:1\n\t"        \
        "v_mul_f32 %9, %3, %17\n\t"                                                                       \
        "v_add_f32_dpp %4, %4, %4 row_half_mirror row_mask:0xf bank_mask:0xf bound_ctrl:1\n\t"            \
        "v_add_f32_dpp %5, %5, %5 row_half_mirror row_mask:0xf bank_mask:0xf bound_ctrl:1\n\t"            \
        "v_fmac_f32 %6, %30, %18\n\t"                                                                     \
        "v_add_f32_dpp %4, %4, %4 row_mirror row_mask:0xf bank_mask:0xf bound_ctrl:1\n\t"                 \
        "v_add_f32_dpp %5, %5, %5 row_mirror row_mask:0xf bank_mask:0xf bound_ctrl:1\n\t"                 \
        "v_fmac_f32 %7, %30, %19\n\t"                                                                     \
        "v_fmac_f32 %8, %30, %20\n\t"                                                                     \
        "v_fmac_f32 %9, %30, %21\n\t"                                                                     \
        "v_fma_f32 %0, %4, %22, %6\n\t"                                                                   \
        "v_fma_f32 %1, %4, %23, %7\n\t"                                                                   \
        "v_fma_f32 %2, %4, %24, %8\n\t"                                                                   \
        "v_fma_f32 %3, %4, %25, %9\n\t"                                                                   \
        : "+v"(S0), "+v"(S1), "+v"(S2), "+v"(S3), "=&v"(sa), "=&v"(yv), "=&v"(t0), "=&v"(t1), "=&v"(t2), "=&v"(t3) \
        : "v"(av##X.x), "v"(av##X.y), "v"(av##X.z), "v"(av##X.w),                                         \
          "v"(dec##X.x), "v"(dec##X.y), "v"(dec##X.z), "v"(dec##X.w),                                     \
          "v"(kv##X.x), "v"(kv##X.y), "v"(kv##X.z), "v"(kv##X.w),                                         \
          "v"(bv##X.x), "v"(bv##X.y), "v"(bv##X.z), "v"(bv##X.w),                                         \
          "v"(rprev.x), "v"(rprev.y), "v"(rprev.z), "v"(rprev.w), "v"(vv##X));                            \
    if ((s) > 0) ykeep = (kq == (s) - 1) ? yv : ykeep;                                                    \
    rprev = rv##X;                                                                                        \
  }
  LDSTEP(A, 0) LDSTEP(B, 1)
  STEP(0, A, C) STEP(1, B, A) STEP(2, C, B) STEP(3, A, C) STEP(4, B, A) STEP(5, C, B)
  STEP(6, A, C) STEP(7, B, A) STEP(8, C, B) STEP(9, A, C) STEP(10, B, A) STEP(11, C, B)
  STEP(12, A, C) STEP(13, B, A) STEP(14, C, B) STEP(15, A, C)
#undef STEP
#undef LDSTEP
  {
    float yv = S0 * rprev.x;
    yv = fmaf(S1, rprev.y, yv); yv = fmaf(S2, rprev.z, yv); yv = fmaf(S3, rprev.w, yv);
    yv = allreduce16(yv);
    ykeep = (kq == 15) ? yv : ykeep;
  }
}

DI void scan_store8(float* d, uint4 r, int mode) {
  float f0 = bflo(r.x), f1 = bfhi(r.x), f2 = bflo(r.y), f3 = bfhi(r.y);
  float f4 = bflo(r.z), f5 = bfhi(r.z), f6 = bflo(r.w), f7 = bfhi(r.w);
  if (mode == 2) { f0 = 1.f - f0; f1 = 1.f - f1; f2 = 1.f - f2; f3 = 1.f - f3; f4 = 1.f - f4; f5 = 1.f - f5; f6 = 1.f - f6; f7 = 1.f - f7; }
  if (mode) { *(float4*)d = float4{f0, f1, f2, f3}; *(float4*)(d + 4) = float4{f4, f5, f6, f7}; }
}

DI void scan_item(const Params& P, int item, char* smem) {
  float* buf = (float*)smem;
  const int tid = threadIdx.x;
  const int qr = item & 3, h = (item >> 2) % 6, b = item / 24;
  const bf16_t* SI = (const bf16_t*)(P.ws + OFF_SI) + (size_t)(b * 6 + h) * 4096 * 384;
  float* yraw = (float*)(P.ws + OFF_YRAW) + (size_t)b * 4096 * 1168 + h * 64 + qr * 16;
  const int kq = tid & 15, rowl = tid >> 4;
  int off0, off1, off2, md0, md1, md2;
#define SCAN_CONST(i, OFF, MD)                                                           \
  {                                                                                      \
    int e = (tid + 256 * (i)) * 8; int step = e / 384; int within = e - step * 384;      \
    int vec = within >> 6, c0 = within & 63;                                             \
    if (vec < 5) { OFF = (step * 5 + vec) * 64 + c0; MD = (vec == 0) ? 2 : 1; }          \
    else if ((c0 >> 4) == qr) { OFF = 5120 + step * 16 + (c0 & 15); MD = 1; }            \
    else { OFF = 0; MD = 0; }                                                            \
  }
  SCAN_CONST(0, off0, md0) SCAN_CONST(1, off1, md1) SCAN_CONST(2, off2, md2)
#undef SCAN_CONST
  const bf16_t* sp = SI + tid * 8;
  uint4 a0, a1, a2, b0, b1, b2, c0, c1, c2, d0, d1, d2;
#define SLOAD(ch, R0, R1, R2) { const bf16_t* q_ = sp + (size_t)(ch) * 6144; R0 = *(const uint4*)q_; R1 = *(const uint4*)(q_ + 2048); R2 = *(const uint4*)(q_ + 4096); }
#define SSTORE(bi, R0, R1, R2) { float* d_ = buf + (bi) * SCAN_BUF; scan_store8(d_ + off0, R0, md0); scan_store8(d_ + off1, R1, md1); scan_store8(d_ + off2, R2, md2); }
#define LBAR { asm volatile("s_waitcnt lgkmcnt(0)" ::: "memory"); __builtin_amdgcn_s_barrier(); }
  __syncthreads();
  SLOAD(0, a0, a1, a2) SLOAD(1, b0, b1, b2) SLOAD(2, c0, c1, c2) SLOAD(3, d0, d1, d2)
  SSTORE(0, a0, a1, a2)
  LBAR
  float S0 = 0.f, S1 = 0.f, S2 = 0.f, S3 = 0.f;
  const float* bb0 = buf + kq * 4;
  const float* bb1 = buf + SCAN_BUF + kq * 4;
  const float* vb0 = buf + 5120 + rowl;
  const float* vb1 = buf + SCAN_BUF + 5120 + rowl;
  float* yp = yraw + (size_t)kq * 1168 + rowl;
  for (int ch = 0; ch < 256; ch += 4) {
    float yk;
    const int n4 = (ch + 4 < 256) ? ch + 4 : 255, n5 = (ch + 5 < 256) ? ch + 5 : 255;
    const int n6 = (ch + 6 < 256) ? ch + 6 : 255, n7 = (ch + 7 < 256) ? ch + 7 : 255;
    yk = 0.f; scan_chunk(bb0, vb0, kq, S0, S1, S2, S3, yk);
    yp[(size_t)(ch + 0) * 16 * 1168] = yk;
    SSTORE(1, b0, b1, b2) SLOAD(n4, a0, a1, a2) LBAR
    yk = 0.f; scan_chunk(bb1, vb1, kq, S0, S1, S2, S3, yk);
    yp[(size_t)(ch + 1) * 16 * 1168] = yk;
    SSTORE(0, c0, c1, c2) SLOAD(n5, b0, b1, b2) LBAR
    yk = 0.f; scan_chunk(bb0, vb0, kq, S0, S1, S2, S3, yk);
    yp[(size_t)(ch + 2) * 16 * 1168] = yk;
    SSTORE(1, d0, d1, d2) SLOAD(n6, c0, c1, c2) LBAR
    yk = 0.f; scan_chunk(bb1, vb1, kq, S0, S1, S2, S3, yk);
    yp[(size_t)(ch + 3) * 16 * 1168] = yk;
    SSTORE(0, a0, a1, a2) SLOAD(n7, d0, d1, d2) LBAR
  }
#undef SLOAD
#undef SSTORE
#undef LBAR
}

DI void load_q(const int* __restrict__ pos, const bf16_t* __restrict__ Q, int b, int h, int t, int quad, float qscale,
               bf16x8& f0, bf16x8& f1, bf16x8& f2) {
  const bf16_t* qrow = Q + ((size_t)b * 4096 + t) * 576 + h * 96;
  {
    uint4 v = *(const uint4*)(qrow + quad * 8);
    uint4 o;
    o.x = pack2(bflo(v.x) * qscale, bfhi(v.x) * qscale); o.y = pack2(bflo(v.y) * qscale, bfhi(v.y) * qscale);
    o.z = pack2(bflo(v.z) * qscale, bfhi(v.z) * qscale); o.w = pack2(bflo(v.w) * qscale, bfhi(v.w) * qscale);
    f0 = __builtin_bit_cast(bf16x8, o);
  }
  {
    uint4 v = *(const uint4*)(qrow + 32 + quad * 8);
    uint4 o;
    o.x = pack2(bflo(v.x) * qscale, bfhi(v.x) * qscale); o.y = pack2(bflo(v.y) * qscale, bfhi(v.y) * qscale);
    o.z = pack2(bflo(v.z) * qscale, bfhi(v.z) * qscale); o.w = pack2(bflo(v.w) * qscale, bfhi(v.w) * qscale);
    f1 = __builtin_bit_cast(bf16x8, o);
  }
  {
    uint4 v = *(const uint4*)(qrow + 64 + quad * 8);
    uint4 u = *(const uint4*)(qrow + 64 + (quad ^ 2) * 8);
    const float posf = (float)pos[(size_t)b * 4096 + t];
    const float sgn = (quad < 2) ? -1.f : 1.f;
    const int fb = (quad & 1) * 8;
    uint4 o;
#define ROPE2(dst, vs, us, j0)                                                                 \
    {                                                                                          \
      float c0, s0, c1, s1;                                                                    \
      fast_sincos(posf * rope_inv_freq(fb + (j0)), s0, c0);                                    \
      fast_sincos(posf * rope_inv_freq(fb + (j0) + 1), s1, c1);                                \
      dst = pack2((bflo(vs) * c0 + sgn * bflo(us) * s0) * qscale, (bfhi(vs) * c1 + sgn * bfhi(us) * s1) * qscale); \
    }
    ROPE2(o.x, v.x, u.x, 0) ROPE2(o.y, v.y, u.y, 2) ROPE2(o.z, v.z, u.z, 4) ROPE2(o.w, v.w, u.w, 6)
#undef ROPE2
    f2 = __builtin_bit_cast(bf16x8, o);
  }
}

DI void attn_item(const Params& P, int item, char* smem) {
  bf16_t* Ks = (bf16_t*)smem;
  bf16_t* Vs = Ks + 2 * 64 * 104;
  const int tid = threadIdx.x, lane = tid & 63, w = tid >> 6, qi = lane & 15, quad = lane >> 4;
  const int qb = 31 - item / 24, bh = item % 24, b = bh / 6, h = bh % 6;
  const bf16_t* Q = (const bf16_t*)(P.ws + OFF_Q);
  const bf16_t* Kn = (const bf16_t*)(P.ws + OFF_KN) + (size_t)bh * 4096 * 64;
  const bf16_t* Kpe = (const bf16_t*)(P.ws + OFF_KPE) + (size_t)b * 4096 * 32;
  const bf16_t* Vt = (const bf16_t*)(P.ws + OFF_VT) + (size_t)bh * 64 * 4096;
  bf16_t* ycat = (bf16_t*)(P.ws + OFF_H);
  const int q0 = qb * 128 + w * 32;
  const float qscale = 0.10206207261596575f * 1.4426950408889634f;
  __syncthreads();
  bf16x8 qfA0, qfA1, qfA2, qfB0, qfB1, qfB2;
  load_q(P.pos, Q, b, h, q0 + qi, quad, qscale, qfA0, qfA1, qfA2);
  load_q(P.pos, Q, b, h, q0 + 16 + qi, quad, qscale, qfB0, qfB1, qfB2);
  f32x4 oacc[4][2];
#pragma unroll
  for (int i = 0; i < 4; ++i) { oacc[i][0] = f32x4{0.f, 0.f, 0.f, 0.f}; oacc[i][1] = f32x4{0.f, 0.f, 0.f, 0.f}; }
  float mrun[2] = {-1e30f, -1e30f}, lrun[2] = {0.f, 0.f};
  const int nkt = (qb + 1) * 2;
  uint4 rk0, rk1, rk2, rv0, rv1;
  const int a_r0 = tid >> 3, a_c0 = (tid & 7) * 8;
  const int a_r2 = tid >> 2, a_c2 = (tid & 3) * 8;
#define ALOAD(kt)                                                                         \
  {                                                                                       \
    rk0 = *(const uint4*)(Kn + ((size_t)(kt) * 64 + a_r0) * 64 + a_c0);                   \
    rk1 = *(const uint4*)(Kn + ((size_t)(kt) * 64 + a_r0 + 32) * 64 + a_c0);              \
    rv0 = *(const uint4*)(Vt + (size_t)a_r0 * 4096 + (kt) * 64 + a_c0);                   \
    rv1 = *(const uint4*)(Vt + (size_t)(a_r0 + 32) * 4096 + (kt) * 64 + a_c0);            \
    rk2 = *(const uint4*)(Kpe + ((size_t)(kt) * 64 + a_r2) * 32 + a_c2);                  \
  }
#define ASTORE(bi)                                                                        \
  {                                                                                       \
    *(uint4*)(Ks + ((bi) * 64 + a_r0) * 104 + a_c0) = rk0;                                \
    *(uint4*)(Ks + ((bi) * 64 + a_r0 + 32) * 104 + a_c0) = rk1;                           \
    *(uint4*)(Vs + ((bi) * 64 + a_r0) * 72 + a_c0) = rv0;                                 \
    *(uint4*)(Vs + ((bi) * 64 + a_r0 + 32) * 72 + a_c0) = rv1;                            \
    *(uint4*)(Ks + ((bi) * 64 + a_r2) * 104 + 64 + a_c2) = rk2;                           \
  }
  ALOAD(0);
  ASTORE(0);
  __syncthreads();
  for (int kt = 0; kt < nkt; ++kt) {
    const int cur = kt & 1;
    if (kt + 1 < nkt) ALOAD(kt + 1);
    if (kt * 64 <= q0 + 31) {
      const bf16_t* ks_ = Ks + cur * 64 * 104;
      const bf16_t* vs_ = Vs + cur * 64 * 72;
      f32x4 st[4][2];
#pragma unroll
      for (int i = 0; i < 4; ++i) { st[i][0] = f32x4{0.f, 0.f, 0.f, 0.f}; st[i][1] = f32x4{0.f, 0.f, 0.f, 0.f}; }
#define QK_STEP(ks, QA, QB)                                                                          \
      _Pragma("unroll") for (int kti = 0; kti < 4; ++kti) {                                          \
        bf16x8 kf = *(const bf16x8*)(ks_ + (kti * 16 + qi) * 104 + (ks) * 32 + quad * 8);           \
        st[kti][0] = __builtin_amdgcn_mfma_f32_16x16x32_bf16(kf, QA, st[kti][0], 0, 0, 0);           \
        st[kti][1] = __builtin_amdgcn_mfma_f32_16x16x32_bf16(kf, QB, st[kti][1], 0, 0, 0);           \
      }
      QK_STEP(0, qfA0, qfB0)
      QK_STEP(1, qfA1, qfB1)
      QK_STEP(2, qfA2, qfB2)
#undef QK_STEP
      const bool need_mask = (kt * 64 + 63 > q0);
#pragma unroll
      for (int qt = 0; qt < 2; ++qt) {
        const int qq = q0 + qt * 16 + qi;
        if (need_mask) {
#pragma unroll
          for (int kti = 0; kti < 4; ++kti)
#pragma unroll
            for (int j = 0; j < 4; ++j) {
              int key = kt * 64 + kti * 16 + quad * 4 + j;
              if (key > qq) st[kti][qt][j] = -1e30f;
            }
        }
        float mx = -1e30f;
#pragma unroll
        for (int kti = 0; kti < 4; ++kti)
#pragma unroll
          for (int j = 0; j < 4; ++j) mx = fmaxf(mx, st[kti][qt][j]);
        mx = fmaxf(mx, __shfl_xor(mx, 16));
        mx = fmaxf(mx, __shfl_xor(mx, 32));
        const float mnew = fmaxf(mrun[qt], mx);
        const float alpha = exp2f(mrun[qt] - mnew);
        float ls = 0.f;
#pragma unroll
        for (int kti = 0; kti < 4; ++kti)
#pragma unroll
          for (int j = 0; j < 4; ++j) { float pv = exp2f(st[kti][qt][j] - mnew); st[kti][qt][j] = pv; ls += pv; }
        lrun[qt] = lrun[qt] * alpha + ls;
        mrun[qt] = mnew;
#pragma unroll
        for (int d = 0; d < 4; ++d) { oacc[d][qt][0] *= alpha; oacc[d][qt][1] *= alpha; oacc[d][qt][2] *= alpha; oacc[d][qt][3] *= alpha; }
      }
#pragma unroll
      for (int k2 = 0; k2 < 2; ++k2) {
        bf16x8 pf[2];
#pragma unroll
        for (int qt = 0; qt < 2; ++qt) {
          uint4 o;
          o.x = pack2(st[k2 * 2][qt][0], st[k2 * 2][qt][1]); o.y = pack2(st[k2 * 2][qt][2], st[k2 * 2][qt][3]);
          o.z = pack2(st[k2 * 2 + 1][qt][0], st[k2 * 2 + 1][qt][1]); o.w = pack2(st[k2 * 2 + 1][qt][2], st[k2 * 2 + 1][qt][3]);
          pf[qt] = __builtin_bit_cast(bf16x8, o);
        }
#pragma unroll
        for (int d = 0; d < 4; ++d) {
          const bf16_t* vp = vs_ + (d * 16 + qi) * 72 + k2 * 32 + quad * 4;
          uint2 lo = *(const uint2*)vp, hi = *(const uint2*)(vp + 16);
          uint4 vv; vv.x = lo.x; vv.y = lo.y; vv.z = hi.x; vv.w = hi.y;
          bf16x8 vf = __builtin_bit_cast(bf16x8, vv);
          oacc[d][0] = __builtin_amdgcn_mfma_f32_16x16x32_bf16(vf, pf[0], oacc[d][0], 0, 0, 0);
          oacc[d][1] = __builtin_amdgcn_mfma_f32_16x16x32_bf16(vf, pf[1], oacc[d][1], 0, 0, 0);
        }
      }
    }
    if (kt + 1 < nkt) ASTORE(cur ^ 1);
    __syncthreads();
  }
#undef ALOAD
#undef ASTORE
#pragma unroll
  for (int qt = 0; qt < 2; ++qt) {
    float l = lrun[qt];
    l += __shfl_xor(l, 16);
    l += __shfl_xor(l, 32);
    const float inv = 1.f / l;
    const size_t m = (size_t)b * 4096 + q0 + qt * 16 + qi;
#pragma unroll
    for (int d = 0; d < 4; ++d) {
      uint2 o; o.x = pack2(oacc[d][qt][0] * inv, oacc[d][qt][1] * inv); o.y = pack2(oacc[d][qt][2] * inv, oacc[d][qt][3] * inv);
      *(uint2*)(ycat + m * 1024 + 640 + h * 64 + d * 16 + quad * 4) = o;
    }
  }
}

DI void post_phase(const Params& P, int l) {
  const float* yraw = (const float*)(P.ws + OFF_YRAW);
  const bf16_t* SI = (const bf16_t*)(P.ws + OFF_SI);
  const float* bonus = (const float*)(P.ws + OFF_BONUS);
  bf16_t* ycat = (bf16_t*)(P.ws + OFF_H);
  const int lane = threadIdx.x & 63, w = threadIdx.x >> 6;
  float lnw[6], lnb[6];
#pragma unroll
  for (int h = 0; h < 6; ++h) { lnw[h] = P.rln_w[l * 384 + h * 64 + lane]; lnb[h] = P.rln_b[l * 384 + h * 64 + lane]; }
  for (int m = blockIdx.x * 4 + w; m < 16384; m += gridDim.x * 4) {
    const int b = m >> 12, t = m & 4095;
    float y[6], v[6], g[6], bo[6];
#pragma unroll
    for (int h = 0; h < 6; ++h) {
      y[h] = yraw[(size_t)m * 1168 + h * 64 + lane];
      v[h] = bf2f(SI[((size_t)(b * 6 + h) * 4096 + t) * 384 + 320 + lane]);
      g[h] = bf2f(ycat[(size_t)m * 1024 + h * 64 + lane]);
      bo[h] = bonus[(size_t)m * 6 + h];
    }
#pragma unroll
    for (int h = 0; h < 6; ++h) {
      float mean = wave_sum(y[h]) * (1.f / 64.f);
      float d = y[h] - mean;
      float var = wave_sum(d * d) * (1.f / 64.f);
      float yn = d * rsqrtf(var + 64e-5f) * lnw[h] + lnb[h];
      float o = (yn + bo[h] * v[h]) * g[h];
      ycat[(size_t)m * 1024 + h * 64 + lane] = f2bfh(o);
    }
  }
}

template <int PH>
DI void run_phase(const Params& P, char* smem, int* s_item, const XcdBarrier& xb) {
  char* ws = P.ws;
  float* mod = (float*)(ws + OFF_MOD);
  int* cnt = (int*)(ws + OFF_CNT);
  bf16_t* Hb = (bf16_t*)(ws + OFF_H);
  if (PH == 0) {
    if (blockIdx.x == 0 && threadIdx.x < 64) cnt[threadIdx.x] = 0;
    mod_items(P, smem);
    convert_layer(P, 0, smem);
    return;
  }
  if (PH == NPHASE - 1) {
    const float* m1 = mod + (size_t)(1 * 4) * 6144;
    row_pass(P.out, (const bf16_t*)(ws + OFF_Y), m1 + 5 * 1024, P.g_post_ffn + 1024, P.out, nullptr, nullptr, nullptr, nullptr);
    return;
  }
  constexpr int l = (PH - 1) / 9, sub = (PH - 1) % 9;
  const float* ml = mod + (size_t)(l * 4) * 6144;
  if (sub == 0) {
    if (l == 0) {
      row_pass(P.x, nullptr, nullptr, nullptr, nullptr, P.g_pre_mix, ml + 1024, ml, Hb);
    } else {
      convert_layer(P, l, smem);
      const float* mp = mod + (size_t)((l - 1) * 4) * 6144;
      row_pass(P.out, (const bf16_t*)(ws + OFF_Y), mp + 5 * 1024, P.g_post_ffn + (l - 1) * 1024, P.out,
               P.g_pre_mix + l * 1024, ml + 1024, ml, Hb);
    }
  } else if (sub == 1) {
    for (int rep = 0; rep < 1 + ((PROBE_REP >> 0) & 1); ++rep)
    gemm_phase<EPI_P>(Hb, 1024, (const bf16_t*)(ws + OFF_WIN), 1024, 19, smem, ws + OFF_P, nullptr);
  } else if (sub == 2) {
    for (int i = blockIdx.x; i < 1536; i += gridDim.x) prep_rwkv_item(P, l, i, smem);
  } else if (sub == 3) {
    const int NS = 96, G = gridDim.x;
    unsigned* sub_ctr = (unsigned*)&cnt[8 + l];
    if (G >= 2 * NS) {
      if ((int)blockIdx.x < NS) {
        __builtin_amdgcn_s_setprio(3);
        scan_item(P, blockIdx.x, smem);
        __builtin_amdgcn_s_setprio(0);
        sub_barrier_wait(sub_ctr, (unsigned)(G - NS));
      } else {
        const int G2 = G - NS, b2 = blockIdx.x - NS;
        for (int i = b2; i < 768; i += G2)
          gemm_tile<EPI_KV>((const bf16_t*)(ws + OFF_P) + 2048, 2336, (const bf16_t*)(ws + OFF_WUKV), 256, (i / 6) * 128, (i % 6) * 128, smem, ws + OFF_KN, ws + OFF_VT);
        int bid = (b2 + G2 - (768 % G2)) % G2;
        for (int i = bid; i < 640; i += G2)
          gemm_tile<EPI_Q>((const bf16_t*)(ws + OFF_P) + 1792, 2336, (const bf16_t*)(ws + OFF_WUQ), 256, (i / 5) * 128, (i % 5) * 128, smem, ws + OFF_Q, nullptr);
        bid = (b2 + G2 - ((768 + 640) % G2)) % G2;
        for (int i = bid; i < 512; i += G2) prep_conv_item(P, l, i, smem);
        bid = (b2 + G2 - ((768 + 640 + 512) % G2)) % G2;
        for (int i = bid; i < 64; i += G2) prep_kpe_item(P, i);
        sub_barrier(sub_ctr, (unsigned)G2);
      }
    } else {
      for (int i = blockIdx.x; i < 768; i += G)
        gemm_tile<EPI_KV>((const bf16_t*)(ws + OFF_P) + 2048, 2336, (const bf16_t*)(ws + OFF_WUKV), 256, (i / 6) * 128, (i % 6) * 128, smem, ws + OFF_KN, ws + OFF_VT);
      for (int i = blockIdx.x; i < 640; i += G)
        gemm_tile<EPI_Q>((const bf16_t*)(ws + OFF_P) + 1792, 2336, (const bf16_t*)(ws + OFF_WUQ), 256, (i / 5) * 128, (i % 5) * 128, smem, ws + OFF_Q, nullptr);
      for (int i = blockIdx.x; i < 512; i += G) prep_conv_item(P, l, i, smem);
      for (int i = blockIdx.x; i < 64; i += G) prep_kpe_item(P, i);
      for (int it = blockIdx.x; it < NS; it += G) scan_item(P, it, smem);
      xcd_barrier(xb);
    }
    while (true) {
      __syncthreads();
      if (threadIdx.x == 0) *s_item = atomicAdd(&cnt[l], 1);
      __syncthreads();
      int item = *s_item;
      if (item >= 768) break;
      attn_item(P, item, smem);
    }
  } else if (sub == 4) {
    post_phase(P, l);
  } else if (sub == 5) {
    for (int rep = 0; rep < 1 + ((PROBE_REP >> 3) & 1); ++rep)
    gemm_phase<EPI_Y>(Hb, 1024, (const bf16_t*)(ws + OFF_WOUT), 1024, 8, smem, ws + OFF_Y, nullptr);
  } else if (sub == 6) {
    const float* xs = (l == 0) ? P.x : P.out;
    row_pass(xs, (const bf16_t*)(ws + OFF_Y), ml + 2 * 1024, P.g_post_mix + l * 1024, P.out,
             P.g_pre_ffn + l * 1024, ml + 4 * 1024, ml + 3 * 1024, Hb);
  } else if (sub == 7) {
    for (int rep = 0; rep < 1 + ((PROBE_REP >> 4) & 1); ++rep)
    gemm_phase<EPI_FF1>(Hb, 1024, (const bf16_t*)(ws + OFF_WFF1), 1024, 32, smem, ws + OFF_HID, nullptr);
  } else if (sub == 8) {
    for (int rep = 0; rep < 1 + ((PROBE_REP >> 5) & 1); ++rep)
    gemm_phase<EPI_Y>((const bf16_t*)(ws + OFF_HID), 4096, (const bf16_t*)(ws + OFF_WFF2), 4096, 8, smem, ws + OFF_Y, nullptr);
  }
}

__global__ void __launch_bounds__(256, 2) fwd_kernel(Params P, int ph_begin, int ph_end, int use_cg) {
  __shared__ __attribute__((aligned(16))) char smem[74752];
  __shared__ int s_item;
  __shared__ uint4 xb_words;
  cg::grid_group grid = cg::this_grid();
  if (threadIdx.x == 0) xb_words = make_uint4(0u, 0u, 0u, 0u);
  __syncthreads();
  XcdBarrier xb = xcd_barrier_post((unsigned*)(P.ws + OFF_BAR), (volatile LAS unsigned*)&xb_words);
#define RUN(k) if (ph_begin <= (k) && (k) < ph_end) { if ((k) > ph_begin) { if (use_cg) grid.sync(); else xcd_barrier(xb); } run_phase<(k)>(P, smem, &s_item, xb); }
  RUN(0) RUN(1) RUN(2) RUN(3) RUN(4) RUN(5) RUN(6) RUN(7) RUN(8) RUN(9)
  RUN(10) RUN(11) RUN(12) RUN(13) RUN(14) RUN(15) RUN(16) RUN(17) RUN(18) RUN(19)
#undef RUN
}

extern "C" void kernel_launch(void* const* d_in, const int* in_sizes, int n_in, void* d_out, int out_size, void* d_ws,
                              size_t ws_size, hipStream_t stream) {
  Params P{};
  P.x = (const float*)d_in[0]; P.c = (const float*)d_in[1]; P.pos = (const int*)d_in[2];
  P.g_pre_mix = (const float*)d_in[3]; P.g_post_mix = (const float*)d_in[4]; P.g_pre_ffn = (const float*)d_in[5];
  P.g_post_ffn = (const float*)d_in[6]; P.w_ada = (const float*)d_in[7]; P.b_ada = (const float*)d_in[8];
  P.w_in = (const float*)d_in[9]; P.w_out = (const float*)d_in[10];
  P.mu = (const float*)d_in[11]; P.w0 = (const float*)d_in[12]; P.w2 = (const float*)d_in[13]; P.a0 = (const float*)d_in[14];
  P.a2 = (const float*)d_in[15]; P.g2 = (const float*)d_in[16]; P.k_k = (const float*)d_in[17]; P.k_a = (const float*)d_in[18];
  P.r_k = (const float*)d_in[19]; P.rln_w = (const float*)d_in[20]; P.rln_b = (const float*)d_in[21];
  P.conv_w = (const float*)d_in[22]; P.conv_b = (const float*)d_in[23]; P.cln_w = (const float*)d_in[24]; P.cln_b = (const float*)d_in[25];
  P.q_norm = (const float*)d_in[26]; P.w_uq = (const float*)d_in[27]; P.kv_norm = (const float*)d_in[28]; P.w_ukv = (const float*)d_in[29];
  P.w_ff1 = (const float*)d_in[30]; P.w_ff2 = (const float*)d_in[31];
  P.out = (float*)d_out; P.ws = (char*)d_ws;
  static int grid_blocks = 0;
  if (!grid_blocks) {
    int dev = 0, cus = 0, per_cu = 0;
    hipGetDevice(&dev);
    hipDeviceGetAttribute(&cus, hipDeviceAttributeMultiprocessorCount, dev);
    hipOccupancyMaxActiveBlocksPerMultiprocessor(&per_cu, fwd_kernel, 256, 0);
    if (per_cu < 1) per_cu = 1;
    if (per_cu > 2) per_cu = 2;
    grid_blocks = cus * per_cu;
  }
#if SINGLE_LAUNCH
  int pb = 0, pe = NPHASE, ucg = 0;
  hipMemsetAsync((char*)d_ws + OFF_BAR, 0, XCD_BAR_WORDS * 4, stream);
  void* args[] = {&P, &pb, &pe, &ucg};
  hipError_t e = hipLaunchCooperativeKernel((void*)fwd_kernel, dim3(grid_blocks), dim3(256), args, 0, stream);
  if (e != hipSuccess) fprintf(stderr, "cooperative launch failed: %s (grid %d)\n", hipGetErrorString(e), grid_blocks);
#else
  for (int ph = 0; ph < NPHASE; ++ph) fwd_kernel<<<grid_blocks, 256, 0, stream>>>(P, ph, ph + 1, 0);
#endif
}
```

```cpp
#include <hip/hip_runtime.h>
#include <hip/hip_cooperative_groups.h>
#include <cstdio>
namespace cg = cooperative_groups;

#ifndef SINGLE_LAUNCH
#define SINGLE_LAUNCH 1
#endif

#ifndef PROBE_SPLIT
#define PROBE_SPLIT 0
#endif
#ifndef PROBE_PREP
#define PROBE_PREP 0
#endif
#ifndef PROBE_REP
#define PROBE_REP 0
#endif
#define DI __device__ __forceinline__
typedef unsigned short bf16_t;
using bf16x8 = __attribute__((ext_vector_type(8))) short;
using f32x4 = __attribute__((ext_vector_type(4))) float;
using f32x2 = __attribute__((ext_vector_type(2))) float;

constexpr int T_SEQ = 4096;
constexpr int NPHASE = 20;

constexpr size_t OFF_WIN = 0;
constexpr size_t OFF_WOUT = OFF_WIN + 2432ull * 1024 * 2;
constexpr size_t OFF_WFF1 = OFF_WOUT + 1024ull * 1024 * 2;
constexpr size_t OFF_WFF2 = OFF_WFF1 + 4096ull * 1024 * 2;
constexpr size_t OFF_WUQ = OFF_WFF2 + 4096ull * 1024 * 2;
constexpr size_t OFF_WUKV = OFF_WUQ + 640ull * 256 * 2;
constexpr size_t OFF_MISC = OFF_WUKV + 768ull * 256 * 2;
constexpr size_t OFF_MOD = OFF_MISC;
constexpr size_t OFF_BONUS = OFF_MISC + 262144;
constexpr size_t OFF_LORA = OFF_MISC + 655360;
constexpr size_t OFF_CNT = OFF_MISC + 786432;
constexpr size_t OFF_BAR = OFF_MISC + 786432 + 4096;
constexpr size_t OFF_H = OFF_MISC + 1048576;
constexpr size_t OFF_ARENA = OFF_H + 16384ull * 1024 * 2;
constexpr size_t OFF_Y = OFF_ARENA;
constexpr size_t OFF_HID = OFF_ARENA + 67108864ull;
constexpr size_t OFF_SI = OFF_ARENA;
constexpr size_t OFF_P = OFF_SI + 16384ull * 6 * 768;
constexpr size_t OFF_Q = OFF_P + 16384ull * 2336 * 2;
constexpr size_t OFF_KN = OFF_Q + 16384ull * 576 * 2;
constexpr size_t OFF_VT = OFF_KN + 16384ull * 384 * 2;
constexpr size_t OFF_KPE = OFF_VT + 16384ull * 384 * 2;
constexpr size_t OFF_YRAW = OFF_P;
static_assert(OFF_KPE + 16384ull * 32 * 2 <= 268435456ull, "ws");
static_assert(OFF_HID + 16384ull * 4096 * 2 <= 268435456ull, "ws");

struct Params {
  const float* x; const float* c; const int* pos;
  const float *g_pre_mix, *g_post_mix, *g_pre_ffn, *g_post_ffn, *w_ada, *b_ada, *w_in, *w_out;
  const float *mu, *w0, *w2, *a0, *a2, *g2, *k_k, *k_a, *r_k, *rln_w, *rln_b;
  const float *conv_w, *conv_b, *cln_w, *cln_b;
  const float *q_norm, *w_uq, *kv_norm, *w_ukv, *w_ff1, *w_ff2;
  float* out;
  char* ws;
};

DI bf16_t f2bf(float x) { unsigned u = __float_as_uint(x); u += 0x7fffu + ((u >> 16) & 1u); return (bf16_t)(u >> 16); }
DI float bf2f(bf16_t h) { return __uint_as_float(((unsigned)h) << 16); }
DI unsigned pack2(float a, float b) { return (unsigned)f2bf(a) | ((unsigned)f2bf(b) << 16); }
typedef __bf16 hwbf2 __attribute__((ext_vector_type(2)));
typedef float hwf2 __attribute__((ext_vector_type(2)));
DI unsigned pack2h(float a, float b) { hwf2 v = {a, b}; return __builtin_bit_cast(unsigned, __builtin_convertvector(v, hwbf2)); }
DI bf16_t f2bfh(float x) { return (bf16_t)(pack2h(x, x) & 0xffffu); }
DI float bflo(unsigned u) { return __uint_as_float(u << 16); }
DI float bfhi(unsigned u) { return __uint_as_float(u & 0xffff0000u); }

DI void fmac(float& acc, float a, float b) { asm("v_fmac_f32 %0, %1, %2" : "+v"(acc) : "v"(a), "v"(b)); }
DI float sigmoidf_(float x) { return __builtin_amdgcn_rcpf(1.f + __expf(-x)); }
template <int CTRL> DI float dppf(float x) {
  return __int_as_float(__builtin_amdgcn_update_dpp(0, __float_as_int(x), CTRL, 0xf, 0xf, true));
}
DI float allreduce16(float x) {
  x += dppf<0xB1>(x);
  x += dppf<0x4E>(x);
  x += dppf<0x141>(x);
  x += dppf<0x140>(x);
  return x;
}
DI float wave_sum(float v) {
  v = allreduce16(v);
  const int iv = __float_as_int(v);
  float s0 = __int_as_float(__builtin_amdgcn_readlane(iv, 0)), s1 = __int_as_float(__builtin_amdgcn_readlane(iv, 16));
  float s2 = __int_as_float(__builtin_amdgcn_readlane(iv, 32)), s3 = __int_as_float(__builtin_amdgcn_readlane(iv, 48));
  return (s0 + s1) + (s2 + s3);
}


#define XB_TMO      128
#define XB_XCNT(j)  (256  + 64 * (j))
#define XB_XSUB(j)  (1280 + 64 * (j))
#define XB_XGEN(j)  (2304 + 64 * (j))
#define XB_TOP      3328
#define XB_TOPGEN   3392
#define XCD_BAR_WORDS 3456
#define XB_SPIN_CAP (1u << 18)
#define LAS __attribute__((address_space(3)))
DI unsigned xb_ld(unsigned* p) { return __hip_atomic_load(p, __ATOMIC_RELAXED, __HIP_MEMORY_SCOPE_AGENT); }
DI unsigned xb_add(unsigned* p, unsigned v) { return __hip_atomic_fetch_add(p, v, __ATOMIC_RELAXED, __HIP_MEMORY_SCOPE_AGENT); }
DI unsigned xb_xcc_id() { return (unsigned)__builtin_amdgcn_s_getreg((3 << 11) | 20) & 0xFu; }
#define XB_SPIN(cond, bar) do { unsigned _sp = 0; while (cond) { __builtin_amdgcn_s_sleep(1); \
    if ((++_sp & 255u) == 0u) { if (xb_ld(&(bar)[XB_TMO])) break; if (_sp > XB_SPIN_CAP) { atomicAdd(&(bar)[XB_TMO], 1u); break; } } } } while (0)
struct XcdBarrier { unsigned* bar; unsigned x; volatile LAS unsigned* st; };
DI XcdBarrier xcd_barrier_post(unsigned* bar, volatile LAS unsigned* st) {
  XcdBarrier b; b.bar = bar; b.x = xb_xcc_id(); b.st = st;
  if (threadIdx.x == 0) (void)xb_add(&bar[XB_XCNT(b.x)], 1u);
  return b;
}
DI void xcd_barrier_complete(unsigned* bar, unsigned x, unsigned& nloc, unsigned& nx) {
  const unsigned G = gridDim.x * gridDim.y * gridDim.z;
  unsigned sum, cnt, mine, sp = 0u;
  for (;;) {
    sum = 0u; cnt = 0u; mine = 0u;
#pragma unroll
    for (unsigned j = 0; j < 16; ++j) { const unsigned c = xb_ld(&bar[XB_XCNT(j)]); sum += c; cnt += (c > 0u) ? 1u : 0u; mine = (j == x) ? c : mine; }
    if (sum == G) break;
    __builtin_amdgcn_s_sleep(1);
    if ((++sp & 255u) == 0u) { if (xb_ld(&bar[XB_TMO])) break; if (sp > XB_SPIN_CAP) { atomicAdd(&bar[XB_TMO], 1u); break; } }
  }
  nloc = mine > 0u ? mine : 1u; nx = cnt > 0u ? cnt : 1u;
}
DI void xcd_barrier(const XcdBarrier& b) {
  asm volatile("s_waitcnt vmcnt(0)" ::: "memory");
  __syncthreads();
  if (threadIdx.x == 0) {
    unsigned* bar = b.bar;
    __builtin_amdgcn_s_waitcnt(0);
    unsigned nloc = b.st[0], nx = b.st[1];
    if (nloc == 0u) { xcd_barrier_complete(bar, b.x, nloc, nx); b.st[0] = nloc; b.st[1] = nx; }
    const unsigned old = xb_add(&bar[XB_XSUB(b.x)], 1u);
    const unsigned gen = old / nloc;
    if (old + 1u == (gen + 1u) * nloc) {
      __builtin_amdgcn_fence(__ATOMIC_RELEASE, "agent");
      asm volatile("s_waitcnt vmcnt(0)" ::: "memory");
      const unsigned og = xb_add(&bar[XB_TOP], 1u);
      const unsigned tg = og / nx;
      if (og + 1u == (tg + 1u) * nx) xb_add(&bar[XB_TOPGEN], 1u);
      else XB_SPIN(xb_ld(&bar[XB_TOPGEN]) == tg, bar);
      __builtin_amdgcn_fence(__ATOMIC_ACQUIRE, "agent");
      xb_add(&bar[XB_XGEN(b.x)], 1u);
      asm volatile("s_waitcnt vmcnt(0)" ::: "memory");
    } else {
      XB_SPIN(xb_ld(&bar[XB_XGEN(b.x)]) == gen, bar);
      __builtin_amdgcn_fence(__ATOMIC_ACQUIRE, "agent");
      asm volatile("s_waitcnt vmcnt(0)" ::: "memory");
    }
  }
  __syncthreads();
}

DI void sub_barrier_wait(unsigned* ctr, unsigned n) {
  if (threadIdx.x == 0) {
    unsigned sp = 0;
    while (xb_ld(ctr) < n) { __builtin_amdgcn_s_sleep(2); if (++sp > (1u << 22)) break; }
    __builtin_amdgcn_fence(__ATOMIC_ACQUIRE, "agent");
    asm volatile("s_waitcnt vmcnt(0)" ::: "memory");
  }
  __syncthreads();
}
DI void sub_barrier(unsigned* ctr, unsigned n) {
  asm volatile("s_waitcnt vmcnt(0)" ::: "memory");
  __syncthreads();
  if (threadIdx.x == 0) {
    __builtin_amdgcn_fence(__ATOMIC_RELEASE, "agent");
    asm volatile("s_waitcnt vmcnt(0)" ::: "memory");
    (void)xb_add(ctr, 1u);
  }
  sub_barrier_wait(ctr, n);
}

DI void convert_tile(const float* __restrict__ W, int Kdim, int Ndim, bf16_t* __restrict__ Wt, int kt, int nt,
                     const float* __restrict__ kscale, char* smem) {
  float (*s)[65] = (float (*)[65])smem;
  const int tid = threadIdx.x;
#pragma unroll
  for (int i = 0; i < 16; ++i) {
    int idx = tid + 256 * i; int kk = idx >> 6, nn = idx & 63;
    int n = nt * 64 + nn, k = kt * 64 + kk;
    float v = (n < Ndim) ? W[(size_t)k * Ndim + n] : 0.f;
    if (kscale) v *= kscale[k];
    s[kk][nn] = v;
  }
  __syncthreads();
#pragma unroll 4
  for (int i = 0; i < 8; ++i) {
    int idx = tid + 256 * i; int nn = idx >> 5, kp = idx & 31;
    unsigned pk = pack2h(s[2 * kp][nn], s[2 * kp + 1][nn]);
    *(unsigned*)(Wt + (size_t)(nt * 64 + nn) * Kdim + kt * 64 + 2 * kp) = pk;
  }
  __syncthreads();
}

DI void convert_layer(const Params& P, int l, char* smem) {
  char* ws = P.ws;
  const int n_in = 16 * 38, n_out = 16 * 16, n_ff1 = 16 * 64, n_ff2 = 64 * 16, n_uq = 4 * 10, n_ukv = 4 * 12;
  const int total = n_in + n_out + n_ff1 + n_ff2 + n_uq + n_ukv;
  for (int it = blockIdx.x; it < 6; it += gridDim.x) {
    bf16_t* lo = (bf16_t*)(ws + OFF_LORA) + it * 8192;
    for (int i = 0; i < 32; ++i) {
      int e = threadIdx.x + 256 * i; int n = e >> 7, k = e & 127; int cg_ = it * 64 + n;
      float v = (k < 32) ? P.w2[((size_t)l * 32 + k) * 384 + cg_] : (k < 64) ? P.a2[((size_t)l * 32 + (k - 32)) * 384 + cg_] : P.g2[((size_t)l * 64 + (k - 64)) * 384 + cg_];
      lo[e] = f2bf(v);
    }
  }
  for (int it = blockIdx.x; it < total; it += gridDim.x) {
    int i = it;
    if (i < n_in) { convert_tile(P.w_in + (size_t)l * 1024 * 2336, 1024, 2336, (bf16_t*)(ws + OFF_WIN), i % 16, i / 16, nullptr, smem); continue; }
    i -= n_in;
    if (i < n_out) { convert_tile(P.w_out + (size_t)l * 1024 * 1024, 1024, 1024, (bf16_t*)(ws + OFF_WOUT), i % 16, i / 16, nullptr, smem); continue; }
    i -= n_out;
    if (i < n_ff1) { convert_tile(P.w_ff1 + (size_t)l * 1024 * 4096, 1024, 4096, (bf16_t*)(ws + OFF_WFF1), i % 16, i / 16, nullptr, smem); continue; }
    i -= n_ff1;
    if (i < n_ff2) { convert_tile(P.w_ff2 + (size_t)l * 4096 * 1024, 4096, 1024, (bf16_t*)(ws + OFF_WFF2), i % 64, i / 64, nullptr, smem); continue; }
    i -= n_ff2;
    if (i < n_uq) { convert_tile(P.w_uq + (size_t)l * 256 * 576, 256, 576, (bf16_t*)(ws + OFF_WUQ), i % 4, i / 4, P.q_norm + l * 256, smem); continue; }
    i -= n_uq;
    convert_tile(P.w_ukv + (size_t)l * 256 * 768, 256, 768, (bf16_t*)(ws + OFF_WUKV), i % 4, i / 4, P.kv_norm + l * 256, smem);
  }
}

DI void mod_items(const Params& P, char* smem) {
  float* cs = (float*)smem;
  float* red = cs + 4096;
  float* mod = (float*)(P.ws + OFF_MOD);
  const int tid = threadIdx.x;
  for (int it = blockIdx.x; it < 192; it += gridDim.x) {
    int l = it / 96, nc = it % 96;
    __syncthreads();
    for (int i = 0; i < 16; ++i) { int idx = tid + 256 * i; float v = P.c[idx]; cs[idx] = v * sigmoidf_(v); }
    __syncthreads();
    int kg = tid >> 6, cn = tid & 63, n = nc * 64 + cn;
    const float* wp = P.w_ada + (size_t)l * 1024 * 6144 + n;
    float a0 = 0, a1 = 0, a2 = 0, a3 = 0;
#pragma unroll 16
    for (int k = kg * 256; k < kg * 256 + 256; ++k) {
      float w = wp[(size_t)k * 6144];
      a0 += cs[k] * w; a1 += cs[1024 + k] * w; a2 += cs[2048 + k] * w; a3 += cs[3072 + k] * w;
    }
    red[(kg * 4 + 0) * 64 + cn] = a0; red[(kg * 4 + 1) * 64 + cn] = a1; red[(kg * 4 + 2) * 64 + cn] = a2; red[(kg * 4 + 3) * 64 + cn] = a3;
    __syncthreads();
    {
      int b = tid >> 6;
      float s = red[(0 * 4 + b) * 64 + cn] + red[(1 * 4 + b) * 64 + cn] + red[(2 * 4 + b) * 64 + cn] + red[(3 * 4 + b) * 64 + cn];
      mod[(size_t)(l * 4 + b) * 6144 + n] = s + P.b_ada[l * 6144 + n];
    }
  }
}

DI void row_pass(const float* xsrc, const bf16_t* __restrict__ y, const float* __restrict__ gate,
                 const float* __restrict__ g_post, float* xdst, const float* __restrict__ g_pre,
                 const float* __restrict__ sc, const float* __restrict__ sh, bf16_t* __restrict__ hdst) {
  const int lane = threadIdx.x & 63, w = threadIdx.x >> 6;
  for (int row0 = (blockIdx.x * 4 + w) * 2; row0 < 16384; row0 += gridDim.x * 8) {
    const int b = row0 >> 12;
    float4 xv[2][4], yv[2][4];
#pragma unroll
    for (int r = 0; r < 2; ++r)
#pragma unroll
      for (int i = 0; i < 4; ++i) {
        xv[r][i] = *(const float4*)(xsrc + (size_t)(row0 + r) * 1024 + lane * 4 + 256 * i);
        if (y) {
          const uint2 yb = *(const uint2*)(y + (size_t)(row0 + r) * 1024 + lane * 4 + 256 * i);
          yv[r][i] = float4{bflo(yb.x), bfhi(yb.x), bflo(yb.y), bfhi(yb.y)};
        }
      }
    if (y) {
      float ss[2];
#pragma unroll
      for (int r = 0; r < 2; ++r) {
        float s = 0;
#pragma unroll
        for (int i = 0; i < 4; ++i) s += yv[r][i].x * yv[r][i].x + yv[r][i].y * yv[r][i].y + yv[r][i].z * yv[r][i].z + yv[r][i].w * yv[r][i].w;
        ss[r] = s;
      }
      ss[0] = wave_sum(ss[0]); ss[1] = wave_sum(ss[1]);
#pragma unroll
      for (int i = 0; i < 4; ++i) {
        int col = lane * 4 + 256 * i;
        float4 g = *(const float4*)(g_post + col);
        float4 gt = *(const float4*)(gate + (size_t)b * 6144 + col);
#pragma unroll
        for (int r = 0; r < 2; ++r) {
          float rstd = rsqrtf(ss[r] * (1.f / 1024.f) + 1e-6f);
          xv[r][i].x += gt.x * (yv[r][i].x * rstd * g.x); xv[r][i].y += gt.y * (yv[r][i].y * rstd * g.y);
          xv[r][i].z += gt.z * (yv[r][i].z * rstd * g.z); xv[r][i].w += gt.w * (yv[r][i].w * rstd * g.w);
        }
      }
    }
    if (xdst) {
#pragma unroll
      for (int r = 0; r < 2; ++r)
#pragma unroll
        for (int i = 0; i < 4; ++i) *(float4*)(xdst + (size_t)(row0 + r) * 1024 + lane * 4 + 256 * i) = xv[r][i];
    }
    if (hdst) {
      float ss[2];
#pragma unroll
      for (int r = 0; r < 2; ++r) {
        float s = 0;
#pragma unroll
        for (int i = 0; i < 4; ++i) s += xv[r][i].x * xv[r][i].x + xv[r][i].y * xv[r][i].y + xv[r][i].z * xv[r][i].z + xv[r][i].w * xv[r][i].w;
        ss[r] = s;
      }
      ss[0] = wave_sum(ss[0]); ss[1] = wave_sum(ss[1]);
#pragma unroll
      for (int i = 0; i < 4; ++i) {
        int col = lane * 4 + 256 * i;
        float4 g = *(const float4*)(g_pre + col);
        float4 s1 = *(const float4*)(sc + (size_t)b * 6144 + col);
        float4 s0 = *(const float4*)(sh + (size_t)b * 6144 + col);
#pragma unroll
        for (int r = 0; r < 2; ++r) {
          float rstd = rsqrtf(ss[r] * (1.f / 1024.f) + 1e-6f);
          float h0 = xv[r][i].x * rstd * g.x * (1.f + s1.x) + s0.x;
          float h1 = xv[r][i].y * rstd * g.y * (1.f + s1.y) + s0.y;
          float h2 = xv[r][i].z * rstd * g.z * (1.f + s1.z) + s0.z;
          float h3 = xv[r][i].w * rstd * g.w * (1.f + s1.w) + s0.w;
          uint2 o; o.x = pack2h(h0, h1); o.y = pack2h(h2, h3);
          *(uint2*)(hdst + (size_t)(row0 + r) * 1024 + col) = o;
        }
      }
    }
  }
}

enum { EPI_P = 0, EPI_Q = 1, EPI_KV = 2, EPI_Y = 3, EPI_FF1 = 4 };

template <int EPI>
DI void gemm_tile(const bf16_t* __restrict__ A, int lda, const bf16_t* __restrict__ Bt, int K, int m0, int n0,
                  char* smem, void* out0, void* out1) {
  bf16_t* As = (bf16_t*)smem;
  bf16_t* Bs = As + 2 * 128 * 64;
  float* rs = (float*)(smem + 73728);
  const int tid = threadIdx.x, lane = tid & 63, w = tid >> 6, wm = w >> 1, wn = w & 1, qi = lane & 15, quad = lane >> 4;
  __syncthreads();
  if (EPI == EPI_Q || EPI == EPI_KV) {
    int row = tid >> 1, half = tid & 1;
    const uint4* src = (const uint4*)(A + (size_t)(m0 + row) * lda + half * 128);
    float ss = 0;
#pragma unroll
    for (int i = 0; i < 16; ++i) {
      uint4 v = src[i];
      float f;
      f = bflo(v.x); ss += f * f; f = bfhi(v.x); ss += f * f;
      f = bflo(v.y); ss += f * f; f = bfhi(v.y); ss += f * f;
      f = bflo(v.z); ss += f * f; f = bfhi(v.z); ss += f * f;
      f = bflo(v.w); ss += f * f; f = bfhi(v.w); ss += f * f;
    }
    ss += __shfl_xor(ss, 1);
    if (half == 0) rs[row] = rsqrtf(ss * (1.f / 256.f) + 1e-6f);
  }
  f32x4 acc[4][4];
#pragma unroll
  for (int i = 0; i < 4; ++i)
#pragma unroll
    for (int j = 0; j < 4; ++j) acc[i][j] = f32x4{0.f, 0.f, 0.f, 0.f};
  uint4 p0, p1, p2, p3, p4, p5, p6, p7;
  uint4 q0, q1, q2, q3, q4, q5, q6, q7;
  const int KT = K >> 6;
  const int lrow = tid >> 3, lcc = tid & 7;
  const bf16_t* Ap = A + (size_t)(m0 + lrow) * lda + lcc * 8;
  const bf16_t* Bp = Bt + (size_t)(n0 + lrow) * K + lcc * 8;
  const int wpos = (lcc ^ ((lrow >> 1) & 7)) * 8;
  bf16_t* Aw = As + lrow * 64 + wpos;
  bf16_t* Bw = Bs + lrow * 64 + wpos;
  const int rp0 = (quad ^ ((qi >> 1) & 7)) * 8, rp1 = rp0 ^ 32;
#define GLOAD(kt, R0, R1, R2, R3, R4, R5, R6, R7)                        \
  {                                                                      \
    R0 = *(const uint4*)(Ap + (size_t)(0) * lda + (kt) * 64);            \
    R1 = *(const uint4*)(Ap + (size_t)(32) * lda + (kt) * 64);           \
    R2 = *(const uint4*)(Ap + (size_t)(64) * lda + (kt) * 64);           \
    R3 = *(const uint4*)(Ap + (size_t)(96) * lda + (kt) * 64);           \
    R4 = *(const uint4*)(Bp + (size_t)(0) * K + (kt) * 64);              \
    R5 = *(const uint4*)(Bp + (size_t)(32) * K + (kt) * 64);             \
    R6 = *(const uint4*)(Bp + (size_t)(64) * K + (kt) * 64);             \
    R7 = *(const uint4*)(Bp + (size_t)(96) * K + (kt) * 64);             \
  }
#define SWRITE(buf, R0, R1, R2, R3, R4, R5, R6, R7)                      \
  {                                                                      \
    *(uint4*)(Aw + ((buf) * 128 + 0) * 64) = R0;                         \
    *(uint4*)(Aw + ((buf) * 128 + 32) * 64) = R1;                        \
    *(uint4*)(Aw + ((buf) * 128 + 64) * 64) = R2;                        \
    *(uint4*)(Aw + ((buf) * 128 + 96) * 64) = R3;                        \
    *(uint4*)(Bw + ((buf) * 128 + 0) * 64) = R4;                         \
    *(uint4*)(Bw + ((buf) * 128 + 32) * 64) = R5;                        \
    *(uint4*)(Bw + ((buf) * 128 + 64) * 64) = R6;                        \
    *(uint4*)(Bw + ((buf) * 128 + 96) * 64) = R7;                        \
  }
#define GLOAD0(kt) GLOAD(kt, p0, p1, p2, p3, p4, p5, p6, p7)
#define GLOAD1(kt) GLOAD(kt, q0, q1, q2, q3, q4, q5, q6, q7)
#define SWRITE0(buf) SWRITE(buf, p0, p1, p2, p3, p4, p5, p6, p7)
#define SWRITE1(buf) SWRITE(buf, q0, q1, q2, q3, q4, q5, q6, q7)
#define LBAR { asm volatile("s_waitcnt lgkmcnt(0)" ::: "memory"); __builtin_amdgcn_s_barrier(); }
#define FRAGS(buf)                                                                                        \
  {                                                                                                       \
    const bf16_t* as = As + (buf) * 128 * 64 + (wm * 64 + qi) * 64;                                       \
    const bf16_t* bs = Bs + (buf) * 128 * 64 + (wn * 64 + qi) * 64;                                       \
    _Pragma("unroll") for (int i = 0; i < 4; ++i) {                                                       \
      af0[i] = *(const bf16x8*)(as + i * 16 * 64 + rp0);                                                  \
      bf0[i] = *(const bf16x8*)(bs + i * 16 * 64 + rp0);                                                  \
    }                                                                                                     \
    _Pragma("unroll") for (int i = 0; i < 4; ++i) af1[i] = *(const bf16x8*)(as + i * 16 * 64 + rp1);      \
    bf1[0] = *(const bf16x8*)(bs + 0 * 16 * 64 + rp1);                                                    \
    bf1[1] = *(const bf16x8*)(bs + 1 * 16 * 64 + rp1);                                                    \
  }
#define MMA(buf, SWR)                                                                                     \
  {                                                                                                       \
    __builtin_amdgcn_s_setprio(1);                                                                        \
    _Pragma("unroll") for (int mt = 0; mt < 4; ++mt)                                                      \
      _Pragma("unroll") for (int nt = 0; nt < 4; ++nt)                                                    \
        acc[mt][nt] = __builtin_amdgcn_mfma_f32_16x16x32_bf16(bf0[nt], af0[mt], acc[mt][nt], 0, 0, 0);    \
    __builtin_amdgcn_sched_barrier(0);                                                                    \
    SWR;                                                                                                  \
    {                                                                                                     \
      const bf16_t* bs = Bs + (buf) * 128 * 64 + (wn * 64 + qi) * 64;                                     \
      bf1[2] = *(const bf16x8*)(bs + 2 * 16 * 64 + rp1);                                                  \
      bf1[3] = *(const bf16x8*)(bs + 3 * 16 * 64 + rp1);                                                  \
    }                                                                                                     \
    _Pragma("unroll") for (int nt = 0; nt < 4; ++nt)                                                      \
      _Pragma("unroll") for (int mt = 0; mt < 4; ++mt)                                                    \
        acc[mt][nt] = __builtin_amdgcn_mfma_f32_16x16x32_bf16(bf1[nt], af1[mt], acc[mt][nt], 0, 0, 0);    \
    __builtin_amdgcn_s_setprio(0);                                                                        \
  }
  bf16x8 af0[4], bf0[4], af1[4], bf1[4];
  GLOAD0(0);
  GLOAD1(1);
  SWRITE0(0);
  LBAR;
  for (int kt = 0; kt < KT; kt += 2) {
    const int k2 = (kt + 2 < KT) ? kt + 2 : KT - 2, k3 = (kt + 3 < KT) ? kt + 3 : KT - 1;
    GLOAD0(k2);
    __builtin_amdgcn_sched_barrier(0);
    FRAGS(0);
    __builtin_amdgcn_sched_barrier(0);
    MMA(0, SWRITE1(1));
    LBAR;
    GLOAD1(k3);
    __builtin_amdgcn_sched_barrier(0);
    FRAGS(1);
    __builtin_amdgcn_sched_barrier(0);
    MMA(1, SWRITE0(0));
    LBAR;
  }
#undef FRAGS
#undef MMA
#undef GLOAD0
#undef GLOAD1
#undef SWRITE0
#undef SWRITE1
#undef GLOAD
#undef SWRITE
#undef LBAR
  if (EPI == EPI_P || EPI == EPI_FF1 || EPI == EPI_Y) {
    bf16_t* Cs = (bf16_t*)smem;
#pragma unroll
    for (int mt = 0; mt < 4; ++mt) {
      const int ml = wm * 64 + mt * 16 + qi;
#pragma unroll
      for (int nt = 0; nt < 4; ++nt) {
        const int nl = wn * 64 + nt * 16 + quad * 4;
        f32x4 v = acc[mt][nt];
        if (EPI == EPI_FF1) {
          float a = fmaxf(v[0], 0.f), b = fmaxf(v[1], 0.f), c = fmaxf(v[2], 0.f), d = fmaxf(v[3], 0.f);
          v[0] = a * a; v[1] = b * b; v[2] = c * c; v[3] = d * d;
        }
        uint2 o; o.x = pack2h(v[0], v[1]); o.y = pack2h(v[2], v[3]);
        *(uint2*)(Cs + ml * 136 + nl) = o;
      }
    }
    asm volatile("s_waitcnt lgkmcnt(0)" ::: "memory");
    __builtin_amdgcn_s_barrier();
    const int ldo = (EPI == EPI_P) ? 2336 : (EPI == EPI_Y) ? 1024 : 4096;
#pragma unroll
    for (int i = 0; i < 8; ++i) {
      const int id = tid + 256 * i, row = id >> 4, cc = (id & 15) * 8;
      uint4 d = *(const uint4*)(Cs + row * 136 + cc);
      if (EPI != EPI_P || n0 + cc < 2336) *(uint4*)((bf16_t*)out0 + (size_t)(m0 + row) * ldo + n0 + cc) = d;
    }
    return;
  }
  if (false) {
    float* Cf = (float*)smem;
#pragma unroll
    for (int mt = 0; mt < 4; ++mt) {
      const int ml = wm * 64 + mt * 16 + qi;
#pragma unroll
      for (int nt = 0; nt < 4; ++nt) {
        const int nl = wn * 64 + nt * 16 + quad * 4;
        f32x4 v = acc[mt][nt];
        *(float4*)(Cf + ml * 132 + nl) = float4{v[0], v[1], v[2], v[3]};
      }
    }
    asm volatile("s_waitcnt lgkmcnt(0)" ::: "memory");
    __builtin_amdgcn_s_barrier();
#pragma unroll
    for (int i = 0; i < 16; ++i) {
      const int id = tid + 256 * i, row = id >> 5, cc = (id & 31) * 4;
      float4 d = *(const float4*)(Cf + row * 132 + cc);
      *(float4*)((float*)out0 + (size_t)(m0 + row) * 1024 + n0 + cc) = d;
    }
    return;
  }
#pragma unroll
  for (int mt = 0; mt < 4; ++mt) {
    const int ml = wm * 64 + mt * 16 + qi;
    const int m = m0 + ml;
    float r = 1.f;
    if (EPI == EPI_Q || EPI == EPI_KV) r = rs[ml];
#pragma unroll
    for (int nt = 0; nt < 4; ++nt) {
      const int nl = wn * 64 + nt * 16 + quad * 4;
      const int n = n0 + nl;
      f32x4 v = acc[mt][nt];
      if (EPI == EPI_P) {
        if (n < 2336) { uint2 o; o.x = pack2(v[0], v[1]); o.y = pack2(v[2], v[3]); *(uint2*)((bf16_t*)out0 + (size_t)m * 2336 + n) = o; }
      } else if (EPI == EPI_Y) {
        *(float4*)((float*)out0 + (size_t)m * 1024 + n) = float4{v[0], v[1], v[2], v[3]};
      } else if (EPI == EPI_FF1) {
        float a = fmaxf(v[0], 0.f), b = fmaxf(v[1], 0.f), c = fmaxf(v[2], 0.f), d = fmaxf(v[3], 0.f);
        uint2 o; o.x = pack2(a * a, b * b); o.y = pack2(c * c, d * d);
        *(uint2*)((bf16_t*)out0 + (size_t)m * 4096 + n) = o;
      } else if (EPI == EPI_Q) {
        if (n < 576) { uint2 o; o.x = pack2(v[0] * r, v[1] * r); o.y = pack2(v[2] * r, v[3] * r); *(uint2*)((bf16_t*)out0 + (size_t)m * 576 + n) = o; }
      } else if (EPI == EPI_KV) {
        const int h = n0 >> 7, b = m >> 12, t = m & 4095;
        if (nl < 64) {
          uint2 o; o.x = pack2(v[0] * r, v[1] * r); o.y = pack2(v[2] * r, v[3] * r);
          *(uint2*)((bf16_t*)out0 + ((size_t)(b * 6 + h) * 4096 + t) * 64 + nl) = o;
        } else {
          bf16_t* vt = (bf16_t*)out1 + ((size_t)(b * 6 + h) * 64 + (nl - 64)) * 4096 + t;
          vt[0] = f2bf(v[0] * r); vt[4096] = f2bf(v[1] * r); vt[8192] = f2bf(v[2] * r); vt[12288] = f2bf(v[3] * r);
        }
      }
    }
  }
}

template <int EPI>
DI void gemm_phase(const bf16_t* A, int lda, const bf16_t* Bt, int K, int NT, char* smem, void* out0, void* out1) {
  if ((NT & 7) == 0 && gridDim.x == 512) {
    const int xcd = blockIdx.x & 7, j = blockIdx.x >> 3;
    const int nsc = NT >> 3, nsuper = 16 * nsc;
    for (int s = xcd; s < nsuper; s += 8) {
      int sm = s / nsc, sn = s - sm * nsc;
      gemm_tile<EPI>(A, lda, Bt, K, (sm * 8 + (j >> 3)) * 128, (sn * 8 + (j & 7)) * 128, smem, out0, out1);
    }
    return;
  }
  if (gridDim.x == 512) {
    const int xcd = blockIdx.x & 7, j = blockIdx.x >> 3;
    for (int idx = j; idx < 16 * NT; idx += 64) {
      int ml = idx / NT, nt = idx - ml * NT;
      gemm_tile<EPI>(A, lda, Bt, K, (xcd * 16 + ml) * 128, nt * 128, smem, out0, out1);
    }
    return;
  }
  const int total = 128 * NT;
  for (int it = blockIdx.x; it < total; it += gridDim.x) {
    int mt = it / NT, nt = it % NT;
    gemm_tile<EPI>(A, lda, Bt, K, mt * 128, nt * 128, smem, out0, out1);
  }
}

DI float ld_shift(const bf16_t* p, size_t m, int t, int col, float mu) {
  const size_t mp = m - (size_t)(t > 0 ? 1 : 0);
  const bf16_t c16 = p[m * 2336 + col], p16 = p[mp * 2336 + col];
  float cur = bf2f(c16);
  float prev = bf2f(p16);
  prev = (t > 0) ? prev : 0.f;
  return cur + (prev - cur) * mu;
}

DI void prep_rwkv_item(const Params& P, int l, int item, char* smem) {
  bf16_t* ZA = (bf16_t*)smem;
  bf16_t* WB = (bf16_t*)(smem + 17408);
  float* ACC = (float*)smem;
  const bf16_t* p = (const bf16_t*)(P.ws + OFF_P);
  bf16_t* SI = (bf16_t*)(P.ws + OFF_SI);
  bf16_t* ycat = (bf16_t*)(P.ws + OFF_H);
  float* bonus = (float*)(P.ws + OFF_BONUS);
  const int tid = threadIdx.x;
  const int h = item % 6, tt = (item / 6) & 63, b = item / 384;
  const int t0 = tt * 64;
  const float* mu = P.mu + l * 1280;
  __syncthreads();
  {
    const bf16_t* lo = (const bf16_t*)(P.ws + OFF_LORA) + h * 8192;
#pragma unroll
    for (int i = 0; i < 4; ++i) {
      int id = tid + 256 * i; int n = id >> 4, kc = (id & 15) * 8;
      *(uint4*)(WB + n * 136 + kc) = *(const uint4*)(lo + n * 128 + kc);
    }
  }
  const float mu_lo = mu[1152 + (tid & 127)];
#pragma unroll 16
  for (int i = 0; i < 32; ++i) {
    int idx = tid + 256 * i; int tok = idx >> 7, j = idx & 127;
    int t = t0 + tok; size_t m = (size_t)b * 4096 + t;
    float z = ld_shift(p, m, t, 1152 + j, mu_lo);
    const float sg_ = sigmoidf_((j < 32) ? 2.f * z : z);
    z = (j < 32) ? (2.f * sg_ - 1.f) : ((j >= 64) ? sg_ : z);
    ZA[tok * 136 + j] = f2bfh(z);
  }
  __syncthreads();
  const int g = tid >> 6, c = tid & 63, col = h * 64 + c;
  {
    const int qi = c & 15, quad = c >> 4;
    bf16x8 af[4];
#pragma unroll
    for (int ks = 0; ks < 4; ++ks) af[ks] = *(const bf16x8*)(ZA + (g * 16 + qi) * 136 + ks * 32 + quad * 8);
    f32x4 cw[4], ca[4], cg2[4];
#pragma unroll
    for (int nt = 0; nt < 4; ++nt) {
      const bf16_t* wb = WB + (nt * 16 + qi) * 136 + quad * 8;
      bf16x8 b0 = *(const bf16x8*)(wb), b1 = *(const bf16x8*)(wb + 32), b2 = *(const bf16x8*)(wb + 64), b3 = *(const bf16x8*)(wb + 96);
      const f32x4 z4 = {0.f, 0.f, 0.f, 0.f};
      cw[nt] = __builtin_amdgcn_mfma_f32_16x16x32_bf16(af[0], b0, z4, 0, 0, 0);
      ca[nt] = __builtin_amdgcn_mfma_f32_16x16x32_bf16(af[1], b1, z4, 0, 0, 0);
      cg2[nt] = __builtin_amdgcn_mfma_f32_16x16x32_bf16(af[2], b2, z4, 0, 0, 0);
      cg2[nt] = __builtin_amdgcn_mfma_f32_16x16x32_bf16(af[3], b3, cg2[nt], 0, 0, 0);
    }
    __syncthreads();
#pragma unroll
    for (int nt = 0; nt < 4; ++nt)
#pragma unroll
      for (int j = 0; j < 4; ++j) {
        const int o = (g * 16 + quad * 4 + j) * 68 + nt * 16 + qi;
        ACC[o] = cw[nt][j]; ACC[64 * 68 + o] = ca[nt][j]; ACC[2 * 64 * 68 + o] = cg2[nt][j];
      }
    asm volatile("s_waitcnt lgkmcnt(0)" ::: "memory");
  }
  const float w0 = P.w0[l * 384 + col], a0 = P.a0[l * 384 + col], kkw = P.k_k[l * 384 + col], kaw = P.k_a[l * 384 + col];
  const float rkw = P.r_k[l * 384 + col];
  const float mu_r = mu[col], mu_k = mu[384 + col], mu_v = mu[768 + col];
#pragma unroll 1
  for (int sub = 0; sub < 4; ++sub) {
    float accw[4], acca[4], accg[4];
    float rsh[4], ksh[4], vsh[4];
#pragma unroll
    for (int i = 0; i < 4; ++i) {
      int t = t0 + g * 16 + sub * 4 + i; size_t m = (size_t)b * 4096 + t;
      rsh[i] = ld_shift(p, m, t, col, mu_r);
      ksh[i] = ld_shift(p, m, t, 384 + col, mu_k);
      vsh[i] = ld_shift(p, m, t, 768 + col, mu_v);
      const int o = (g * 16 + sub * 4 + i) * 68 + c;
      accw[i] = ACC[o]; acca[i] = ACC[64 * 68 + o]; accg[i] = ACC[2 * 64 * 68 + o];
    }
    bf16_t* stg = (bf16_t*)(smem + 52224) + g * 896;
#pragma unroll
    for (int pr = 0; pr < 2; ++pr) {
      float bonv[2];
#pragma unroll
      for (int tk = 0; tk < 2; ++tk) {
        const int i = pr * 2 + tk;
        int t = t0 + g * 16 + sub * 4 + i; size_t m = (size_t)b * 4096 + t;
        float r = rsh[i], k = ksh[i], v = vsh[i];
        float xw = -(w0 + accw[i]);
        float sp = fmaxf(xw, 0.f) + __logf(1.f + __expf(-fabsf(xw)));
        float wl_ = -sp - 0.5f;
        float delta = 1.f - __expf(-__expf(wl_));
        float a = sigmoidf_(a0 + acca[i]);
        float kk = k * kkw;
        float ss = wave_sum(kk * kk);
        kk *= rsqrtf(fmaxf(ss, 1e-24f));
        float k2 = k * (1.f + (a - 1.f) * kaw);
        float bon = wave_sum(r * k2 * rkw);
        bf16_t* sg = stg + tk * 448 + c;
        sg[0] = f2bfh(delta); sg[64] = f2bfh(k2); sg[128] = f2bfh(-kk); sg[192] = f2bfh(kk * a); sg[256] = f2bfh(r); sg[320] = f2bfh(v);
        sg[384] = f2bfh(accg[i]);
        bonv[tk] = bon;
      }
      asm volatile("s_waitcnt lgkmcnt(0)" ::: "memory");
#pragma unroll
      for (int tk = 0; tk < 2; ++tk) {
        const int i = pr * 2 + tk;
        int t = t0 + g * 16 + sub * 4 + i; size_t m = (size_t)b * 4096 + t;
        if (c < 56) {
          uint4 d = *(const uint4*)(stg + tk * 448 + c * 8);
          bf16_t* dst = (c < 48) ? (SI + ((size_t)(b * 6 + h) * 4096 + t) * 384 + c * 8) : (ycat + m * 1024 + h * 64 + (c - 48) * 8);
          *(uint4*)dst = d;
        }
        if (c == 56) bonus[m * 6 + h] = bonv[tk];
      }
      asm volatile("s_waitcnt lgkmcnt(0)" ::: "memory");
    }
  }
}

DI void prep_conv_item(const Params& P, int l, int item, char* smem) {
  float* cv = (float*)smem;
  const bf16_t* p = (const bf16_t*)(P.ws + OFF_P);
  bf16_t* ycat = (bf16_t*)(P.ws + OFF_H);
  const int tid = threadIdx.x;
  const int b = item >> 7, t0 = (item & 127) * 32;
  __syncthreads();
  {
    const int c = tid;
    float hw[62];
#pragma unroll
    for (int j = 0; j < 62; ++j) {
      int t = t0 - 30 + j;
      const int tc = t < 0 ? 0 : t;
      size_t m = (size_t)b * 4096 + tc;
      float u = bf2f(p[m * 2336 + 1280 + c]);
      float gt = bf2f(p[m * 2336 + 1536 + c]);
      float hv = u * sigmoidf_(gt);
      hw[j] = (t >= 0) ? hv : 0.f;
    }
    float wj[31];
#pragma unroll
    for (int j = 0; j < 31; ++j) wj[j] = P.conv_w[(size_t)l * 31 * 256 + j * 256 + c];
    const float bias = P.conv_b[l * 256 + c];
#pragma unroll
    for (int i = 0; i < 32; ++i) {
      float o = bias;
#pragma unroll
      for (int j = 0; j < 31; ++j) fmac(o, hw[i + j], wj[j]);
      cv[i * 256 + c] = o;
    }
  }
  __syncthreads();
  const int w = tid >> 6, lane = tid & 63;
  float lnw[4], lnb[4];
#pragma unroll
  for (int q = 0; q < 4; ++q) { lnw[q] = P.cln_w[l * 256 + lane + 64 * q]; lnb[q] = P.cln_b[l * 256 + lane + 64 * q]; }
  for (int i = 0; i < 8; ++i) {
    int tok = w * 8 + i;
    float v[4]; float s = 0;
#pragma unroll
    for (int q = 0; q < 4; ++q) { v[q] = cv[tok * 256 + lane + 64 * q]; s += v[q]; }
    float mean = wave_sum(s) * (1.f / 256.f);
    float s2 = 0;
#pragma unroll
    for (int q = 0; q < 4; ++q) { float d = v[q] - mean; s2 += d * d; }
    float rstd = rsqrtf(wave_sum(s2) * (1.f / 256.f) + 1e-5f);
    size_t m = (size_t)b * 4096 + t0 + tok;
#pragma unroll
    for (int q = 0; q < 4; ++q) {
      int c = lane + 64 * q;
      float yv = (v[q] - mean) * rstd * lnw[q] + lnb[q];
      ycat[m * 1024 + 384 + c] = f2bf(yv * sigmoidf_(yv));
    }
  }
}

DI float rope_inv_freq(int i) { return exp2f(-(float)i * (13.287712379549449f / 16.f)); }
DI void fast_sincos(float ang, float& s, float& c) {
  float n = rintf(ang * 0.15915494309189535f);
  float r = fmaf(-n, 6.2831855f, ang);
  r = fmaf(-n, -1.7484555e-7f, r);
  s = __sinf(r); c = __cosf(r);
}

DI void prep_kpe_item(const Params& P, int item) {
  const bf16_t* p = (const bf16_t*)(P.ws + OFF_P);
  bf16_t* kpe = (bf16_t*)(P.ws + OFF_KPE);
  const int tid = threadIdx.x;
#pragma unroll 8
  for (int i = 0; i < 16; ++i) {
    int idx = tid + 256 * i;
    size_t m = (size_t)item * 256 + (idx >> 4); int fi = idx & 15;
    float x1 = bf2f(p[m * 2336 + 2304 + fi]), x2 = bf2f(p[m * 2336 + 2320 + fi]);
    float ang = (float)P.pos[m] * rope_inv_freq(fi);
    float cs, sn; fast_sincos(ang, sn, cs);
    kpe[m * 32 + fi] = f2bf(x1 * cs - x2 * sn);
    kpe[m * 32 + 16 + fi] = f2bf(x2 * cs + x1 * sn);
  }
}

constexpr int SCAN_BUF = 16 * 5 * 64 + 256;

struct ScanPre { float4 d0, k0, a0, b0, r0, d1, k1, a1, b1, r1; float v0, v1; };
DI void scan_preread(ScanPre& p, const float* bb, const float* vb) {
  p.d0 = *(const float4*)(bb + 0 * 64); p.k0 = *(const float4*)(bb + 1 * 64); p.a0 = *(const float4*)(bb + 2 * 64);
  p.b0 = *(const float4*)(bb + 3 * 64); p.r0 = *(const float4*)(bb + 4 * 64); p.v0 = vb[0];
  p.d1 = *(const float4*)(bb + 320 + 0 * 64); p.k1 = *(const float4*)(bb + 320 + 1 * 64); p.a1 = *(const float4*)(bb + 320 + 2 * 64);
  p.b1 = *(const float4*)(bb + 320 + 3 * 64); p.r1 = *(const float4*)(bb + 320 + 4 * 64); p.v1 = vb[16];
}
DI void scan_chunk(const float* bb, const float* vb, const float* bbn, const float* vbn, ScanPre& pre, int kq,
                   float& S0, float& S1, float& S2, float& S3, float& ykeep) {
  float4 decA = pre.d0, kvA = pre.k0, avA = pre.a0, bvA = pre.b0, rvA = pre.r0;
  float4 decB = pre.d1, kvB = pre.k1, avB = pre.a1, bvB = pre.b1, rvB = pre.r1;
  float4 decC, kvC, avC, bvC, rvC;
  float vvA = pre.v0, vvB = pre.v1, vvC;
  float4 rprev = {0.f, 0.f, 0.f, 0.f};
#define LDSTEP(X, s)                                                                                      \
  {                                                                                                       \
    const float* bn = bb + (s) * 320;                                                                     \
    dec##X = *(const float4*)(bn + 0 * 64); kv##X = *(const float4*)(bn + 1 * 64);                        \
    av##X = *(const float4*)(bn + 2 * 64); bv##X = *(const float4*)(bn + 3 * 64);                         \
    rv##X = *(const float4*)(bn + 4 * 64); vv##X = vb[(s) * 16];                                          \
  }
#define STEP(s, X, PF)                                                                                    \
  {                                                                                                       \
    if ((s) + 2 < 16) LDSTEP(PF, (s) + 2)                                                                 \
    float sa, yv, t0, t1, t2, t3;                                                                         \
    asm volatile(                                                                                         \
        "v_mul_f32 %4, %0, %10\n\t"                                                                       \
        "v_mul_f32 %5, %0, %26\n\t"                                                                       \
        "v_fmac_f32 %4, %1, %11\n\t"                                                                      \
        "v_fmac_f32 %5, %1, %27\n\t"                                                                      \
        "v_fmac_f32 %4, %2, %12\n\t"                                                                      \
        "v_fmac_f32 %5, %2, %28\n\t"                                                                      \
        "v_fmac_f32 %4, %3, %13\n\t"                                                                      \
        "v_fmac_f32 %5, %3, %29\n\t"                                                                      \
        "v_mul_f32 %6, %0, %14\n\t"                                                                       \
        "v_mul_f32 %7, %1, %15\n\t"                                                                       \
        "v_add_f32_dpp %4, %4, %4 quad_perm:[1,0,3,2] row_mask:0xf bank_mask:0xf bound_ctrl:1\n\t"        \
        "v_add_f32_dpp %5, %5, %5 quad_perm:[1,0,3,2] row_mask:0xf bank_mask:0xf bound_ctrl:1\n\t"        \
        "v_mul_f32 %8, %2, %16\n\t"                                                                       \
        "v_add_f32_dpp %4, %4, %4 quad_perm:[2,3,0,1] row_mask:0xf bank_mask:0xf bound_ctrl:1\n\t"        \
        "v_add_f32_dpp %5, %5, %5 quad_perm:[2,3,0,1] row_mask:0xf bank_mask:0xf bound_ctrl:1\n\t"        \
        "v_mul_f32 %9, %3, %17\n\t"                                                                       \
        "v_add_f32_dpp %4, %4, %4 row_half_mirror row_mask:0xf bank_mask:0xf bound_ctrl:1\n\t"            \
        "v_add_f32_dpp %5, %5, %5 row_half_mirror row_mask:0xf bank_mask:0xf bound_ctrl:1\n\t"            \
        "v_fmac_f32 %6, %30, %18\n\t"                                                                     \
        "v_add_f32_dpp %4, %4, %4 row_mirror row_mask:0xf bank_mask:0xf bound_ctrl:1\n\t"                 \
        "v_add_f32_dpp %5, %5, %5 row_mirror row_mask:0xf bank_mask:0xf bound_ctrl:1\n\t"                 \
        "v_fmac_f32 %7, %30, %19\n\t"                                                                     \
        "v_fmac_f32 %8, %30, %20\n\t"                                                                     \
        "v_fmac_f32 %9, %30, %21\n\t"                                                                     \
        "v_fma_f32 %0, %4, %22, %6\n\t"                                                                   \
        "v_fma_f32 %1, %4, %23, %7\n\t"                                                                   \
        "v_fma_f32 %2, %4, %24, %8\n\t"                                                                   \
        "v_fma_f32 %3, %4, %25, %9\n\t"                                                                   \
        : "+v"(S0), "+v"(S1), "+v"(S2), "+v"(S3), "=&v"(sa), "=&v"(yv), "=&v"(t0), "=&v"(t1), "=&v"(t2), "=&v"(t3) \
        : "v"(av##X.x), "v"(av##X.y), "v"(av##X.z), "v"(av##X.w),                                         \
          "v"(dec##X.x), "v"(dec##X.y), "v"(dec##X.z), "v"(dec##X.w),                                     \
          "v"(kv##X.x), "v"(kv##X.y), "v"(kv##X.z), "v"(kv##X.w),                                         \
          "v"(bv##X.x), "v"(bv##X.y), "v"(bv##X.z), "v"(bv##X.w),                                         \
          "v"(rprev.x), "v"(rprev.y), "v"(rprev.z), "v"(rprev.w), "v"(vv##X));                            \
    if ((s) > 0) ykeep = (kq == (s) - 1) ? yv : ykeep;                                                    \
    rprev = rv##X;                                                                                        \
  }
  STEP(0, A, C) STEP(1, B, A) STEP(2, C, B) STEP(3, A, C) STEP(4, B, A) STEP(5, C, B)
  STEP(6, A, C) STEP(7, B, A) STEP(8, C, B) STEP(9, A, C) STEP(10, B, A) STEP(11, C, B)
  STEP(12, A, C) STEP(13, B, A)
  scan_preread(pre, bbn, vbn);
  __builtin_amdgcn_sched_barrier(0);
  STEP(14, C, B) STEP(15, A, C)
#undef STEP
#undef LDSTEP
  {
    float yv = S0 * rprev.x;
    yv = fmaf(S1, rprev.y, yv); yv = fmaf(S2, rprev.z, yv); yv = fmaf(S3, rprev.w, yv);
    yv = allreduce16(yv);
    ykeep = (kq == 15) ? yv : ykeep;
  }
}

DI void scan_store8(float* d, uint4 r, int mode) {
  float f0 = bflo(r.x), f1 = bfhi(r.x), f2 = bflo(r.y), f3 = bfhi(r.y);
  float f4 = bflo(r.z), f5 = bfhi(r.z), f6 = bflo(r.w), f7 = bfhi(r.w);
  if (mode == 2) { f0 = 1.f - f0; f1 = 1.f - f1; f2 = 1.f - f2; f3 = 1.f - f3; f4 = 1.f - f4; f5 = 1.f - f5; f6 = 1.f - f6; f7 = 1.f - f7; }
  if (mode) { *(float4*)d = float4{f0, f1, f2, f3}; *(float4*)(d + 4) = float4{f4, f5, f6, f7}; }
}

DI void scan_item(const Params& P, int item, char* smem) {
  float* buf = (float*)smem;
  const int tid = threadIdx.x;
  const int qr = item & 3, h = (item >> 2) % 6, b = item / 24;
  const bf16_t* SI = (const bf16_t*)(P.ws + OFF_SI) + (size_t)(b * 6 + h) * 4096 * 384;
  float* yraw = (float*)(P.ws + OFF_YRAW) + (size_t)b * 4096 * 1168 + h * 64 + qr * 16;
  const int kq = tid & 15, rowl = tid >> 4;
  int off0, off1, off2, md0, md1, md2;
#define SCAN_CONST(i, OFF, MD)                                                           \
  {                                                                                      \
    int e = (tid + 256 * (i)) * 8; int step = e / 384; int within = e - step * 384;      \
    int vec = within >> 6, c0 = within & 63;                                             \
    if (vec < 5) { OFF = (step * 5 + vec) * 64 + c0; MD = (vec == 0) ? 2 : 1; }          \
    else if ((c0 >> 4) == qr) { OFF = 5120 + step * 16 + (c0 & 15); MD = 1; }            \
    else { OFF = 0; MD = 0; }                                                            \
  }
  SCAN_CONST(0, off0, md0) SCAN_CONST(1, off1, md1) SCAN_CONST(2, off2, md2)
#undef SCAN_CONST
  const bf16_t* sp = SI + tid * 8;
  uint4 a0, a1, a2, b0, b1, b2, c0, c1, c2;
#define SLOAD(ch, R0, R1, R2) { const bf16_t* q_ = sp + (size_t)(ch) * 6144; R0 = *(const uint4*)q_; R1 = *(const uint4*)(q_ + 2048); R2 = *(const uint4*)(q_ + 4096); }
#define SSTORE(bi, R0, R1, R2) { float* d_ = buf + (bi) * SCAN_BUF; scan_store8(d_ + off0, R0, md0); scan_store8(d_ + off1, R1, md1); scan_store8(d_ + off2, R2, md2); }
#define LBAR { asm volatile("s_waitcnt lgkmcnt(0)" ::: "memory"); __builtin_amdgcn_s_barrier(); }
#define CL(x) (((x) < 256) ? (x) : 255)
  __syncthreads();
  SLOAD(0, a0, a1, a2) SLOAD(1, b0, b1, b2) SLOAD(2, c0, c1, c2)
  SSTORE(0, a0, a1, a2) SSTORE(1, b0, b1, b2)
  SLOAD(3, a0, a1, a2) SLOAD(4, b0, b1, b2)
  LBAR
  float S0 = 0.f, S1 = 0.f, S2 = 0.f, S3 = 0.f;
  const float* bb0 = buf + kq * 4;
  const float* bb1 = buf + SCAN_BUF + kq * 4;
  const float* bb2 = buf + 2 * SCAN_BUF + kq * 4;
  const float* vb0 = buf + 5120 + rowl;
  const float* vb1 = buf + SCAN_BUF + 5120 + rowl;
  const float* vb2 = buf + 2 * SCAN_BUF + 5120 + rowl;
  float* yp = yraw + (size_t)kq * 1168 + rowl;
  ScanPre pre;
  scan_preread(pre, bb0, vb0);
  float yk;
  for (int ch = 0; ch < 255; ch += 3) {
    SSTORE(2, c0, c1, c2) SLOAD(CL(ch + 5), c0, c1, c2)
    yk = 0.f; scan_chunk(bb0, vb0, bb1, vb1, pre, kq, S0, S1, S2, S3, yk);
    yp[(size_t)(ch + 0) * 16 * 1168] = yk;
    LBAR
    SSTORE(0, a0, a1, a2) SLOAD(CL(ch + 6), a0, a1, a2)
    yk = 0.f; scan_chunk(bb1, vb1, bb2, vb2, pre, kq, S0, S1, S2, S3, yk);
    yp[(size_t)(ch + 1) * 16 * 1168] = yk;
    LBAR
    SSTORE(1, b0, b1, b2) SLOAD(CL(ch + 7), b0, b1, b2)
    yk = 0.f; scan_chunk(bb2, vb2, bb0, vb0, pre, kq, S0, S1, S2, S3, yk);
    yp[(size_t)(ch + 2) * 16 * 1168] = yk;
    LBAR
  }
  yk = 0.f; scan_chunk(bb0, vb0, bb1, vb1, pre, kq, S0, S1, S2, S3, yk);
  yp[(size_t)255 * 16 * 1168] = yk;
#undef CL
#undef SLOAD
#undef SSTORE
#undef LBAR
}

DI void load_q(const int* __restrict__ pos, const bf16_t* __restrict__ Q, int b, int h, int t, int quad, float qscale,
               bf16x8& f0, bf16x8& f1, bf16x8& f2) {
  const bf16_t* qrow = Q + ((size_t)b * 4096 + t) * 576 + h * 96;
  {
    uint4 v = *(const uint4*)(qrow + quad * 8);
    uint4 o;
    o.x = pack2(bflo(v.x) * qscale, bfhi(v.x) * qscale); o.y = pack2(bflo(v.y) * qscale, bfhi(v.y) * qscale);
    o.z = pack2(bflo(v.z) * qscale, bfhi(v.z) * qscale); o.w = pack2(bflo(v.w) * qscale, bfhi(v.w) * qscale);
    f0 = __builtin_bit_cast(bf16x8, o);
  }
  {
    uint4 v = *(const uint4*)(qrow + 32 + quad * 8);
    uint4 o;
    o.x = pack2(bflo(v.x) * qscale, bfhi(v.x) * qscale); o.y = pack2(bflo(v.y) * qscale, bfhi(v.y) * qscale);
    o.z = pack2(bflo(v.z) * qscale, bfhi(v.z) * qscale); o.w = pack2(bflo(v.w) * qscale, bfhi(v.w) * qscale);
    f1 = __builtin_bit_cast(bf16x8, o);
  }
  {
    uint4 v = *(const uint4*)(qrow + 64 + quad * 8);
    uint4 u = *(const uint4*)(qrow + 64 + (quad ^ 2) * 8);
    const float posf = (float)pos[(size_t)b * 4096 + t];
    const float sgn = (quad < 2) ? -1.f : 1.f;
    const int fb = (quad & 1) * 8;
    uint4 o;
#define ROPE2(dst, vs, us, j0)                                                                 \
    {                                                                                          \
      float c0, s0, c1, s1;                                                                    \
      fast_sincos(posf * rope_inv_freq(fb + (j0)), s0, c0);                                    \
      fast_sincos(posf * rope_inv_freq(fb + (j0) + 1), s1, c1);                                \
      dst = pack2((bflo(vs) * c0 + sgn * bflo(us) * s0) * qscale, (bfhi(vs) * c1 + sgn * bfhi(us) * s1) * qscale); \
    }
    ROPE2(o.x, v.x, u.x, 0) ROPE2(o.y, v.y, u.y, 2) ROPE2(o.z, v.z, u.z, 4) ROPE2(o.w, v.w, u.w, 6)
#undef ROPE2
    f2 = __builtin_bit_cast(bf16x8, o);
  }
}

DI void attn_item(const Params& P, int item, char* smem) {
  bf16_t* Ks = (bf16_t*)smem;
  bf16_t* Vs = Ks + 2 * 64 * 104;
  const int tid = threadIdx.x, lane = tid & 63, w = tid >> 6, qi = lane & 15, quad = lane >> 4;
  const int qb = 31 - item / 24, bh = item % 24, b = bh / 6, h = bh % 6;
  const bf16_t* Q = (const bf16_t*)(P.ws + OFF_Q);
  const bf16_t* Kn = (const bf16_t*)(P.ws + OFF_KN) + (size_t)bh * 4096 * 64;
  const bf16_t* Kpe = (const bf16_t*)(P.ws + OFF_KPE) + (size_t)b * 4096 * 32;
  const bf16_t* Vt = (const bf16_t*)(P.ws + OFF_VT) + (size_t)bh * 64 * 4096;
  bf16_t* ycat = (bf16_t*)(P.ws + OFF_H);
  const int q0 = qb * 128 + w * 32;
  const float qscale = 0.10206207261596575f * 1.4426950408889634f;
  __syncthreads();
  bf16x8 qfA0, qfA1, qfA2, qfB0, qfB1, qfB2;
  load_q(P.pos, Q, b, h, q0 + qi, quad, qscale, qfA0, qfA1, qfA2);
  load_q(P.pos, Q, b, h, q0 + 16 + qi, quad, qscale, qfB0, qfB1, qfB2);
  f32x4 oacc[4][2];
#pragma unroll
  for (int i = 0; i < 4; ++i) { oacc[i][0] = f32x4{0.f, 0.f, 0.f, 0.f}; oacc[i][1] = f32x4{0.f, 0.f, 0.f, 0.f}; }
  float mrun[2] = {-1e30f, -1e30f}, lrun[2] = {0.f, 0.f};
  const int nkt = (qb + 1) * 2;
  uint4 rk0, rk1, rk2, rv0, rv1;
  const int a_r0 = tid >> 3, a_c0 = (tid & 7) * 8;
  const int a_r2 = tid >> 2, a_c2 = (tid & 3) * 8;
#define ALOAD(kt)                                                                         \
  {                                                                                       \
    rk0 = *(const uint4*)(Kn + ((size_t)(kt) * 64 + a_r0) * 64 + a_c0);                   \
    rk1 = *(const uint4*)(Kn + ((size_t)(kt) * 64 + a_r0 + 32) * 64 + a_c0);              \
    rv0 = *(const uint4*)(Vt + (size_t)a_r0 * 4096 + (kt) * 64 + a_c0);                   \
    rv1 = *(const uint4*)(Vt + (size_t)(a_r0 + 32) * 4096 + (kt) * 64 + a_c0);            \
    rk2 = *(const uint4*)(Kpe + ((size_t)(kt) * 64 + a_r2) * 32 + a_c2);                  \
  }
#define ASTORE(bi)                                                                        \
  {                                                                                       \
    *(uint4*)(Ks + ((bi) * 64 + a_r0) * 104 + a_c0) = rk0;                                \
    *(uint4*)(Ks + ((bi) * 64 + a_r0 + 32) * 104 + a_c0) = rk1;                           \
    *(uint4*)(Vs + ((bi) * 64 + a_r0) * 72 + a_c0) = rv0;                                 \
    *(uint4*)(Vs + ((bi) * 64 + a_r0 + 32) * 72 + a_c0) = rv1;                            \
    *(uint4*)(Ks + ((bi) * 64 + a_r2) * 104 + 64 + a_c2) = rk2;                           \
  }
  ALOAD(0);
  ASTORE(0);
  __syncthreads();
  for (int kt = 0; kt < nkt; ++kt) {
    const int cur = kt & 1;
    if (kt + 1 < nkt) ALOAD(kt + 1);
    if (kt * 64 <= q0 + 31) {
      const bf16_t* ks_ = Ks + cur * 64 * 104;
      const bf16_t* vs_ = Vs + cur * 64 * 72;
      f32x4 st[4][2];
#pragma unroll
      for (int i = 0; i < 4; ++i) { st[i][0] = f32x4{0.f, 0.f, 0.f, 0.f}; st[i][1] = f32x4{0.f, 0.f, 0.f, 0.f}; }
#define QK_STEP(ks, QA, QB)                                                                          \
      _Pragma("unroll") for (int kti = 0; kti < 4; ++kti) {                                          \
        bf16x8 kf = *(const bf16x8*)(ks_ + (kti * 16 + qi) * 104 + (ks) * 32 + quad * 8);           \
        st[kti][0] = __builtin_amdgcn_mfma_f32_16x16x32_bf16(kf, QA, st[kti][0], 0, 0, 0);           \
        st[kti][1] = __builtin_amdgcn_mfma_f32_16x16x32_bf16(kf, QB, st[kti][1], 0, 0, 0);           \
      }
      QK_STEP(0, qfA0, qfB0)
      QK_STEP(1, qfA1, qfB1)
      QK_STEP(2, qfA2, qfB2)
#undef QK_STEP
      const bool need_mask = (kt * 64 + 63 > q0);
#pragma unroll
      for (int qt = 0; qt < 2; ++qt) {
        const int qq = q0 + qt * 16 + qi;
        if (need_mask) {
#pragma unroll
          for (int kti = 0; kti < 4; ++kti)
#pragma unroll
            for (int j = 0; j < 4; ++j) {
              int key = kt * 64 + kti * 16 + quad * 4 + j;
              if (key > qq) st[kti][qt][j] = -1e30f;
            }
        }
        float mx = -1e30f;
#pragma unroll
        for (int kti = 0; kti < 4; ++kti)
#pragma unroll
          for (int j = 0; j < 4; ++j) mx = fmaxf(mx, st[kti][qt][j]);
        mx = fmaxf(mx, __shfl_xor(mx, 16));
        mx = fmaxf(mx, __shfl_xor(mx, 32));
        const float mnew = fmaxf(mrun[qt], mx);
        const float alpha = exp2f(mrun[qt] - mnew);
        float ls = 0.f;
#pragma unroll
        for (int kti = 0; kti < 4; ++kti)
#pragma unroll
          for (int j = 0; j < 4; ++j) { float pv = exp2f(st[kti][qt][j] - mnew); st[kti][qt][j] = pv; ls += pv; }
        lrun[qt] = lrun[qt] * alpha + ls;
        mrun[qt] = mnew;
#pragma unroll
        for (int d = 0; d < 4; ++d) { oacc[d][qt][0] *= alpha; oacc[d][qt][1] *= alpha; oacc[d][qt][2] *= alpha; oacc[d][qt][3] *= alpha; }
      }
#pragma unroll
      for (int k2 = 0; k2 < 2; ++k2) {
        bf16x8 pf[2];
#pragma unroll
        for (int qt = 0; qt < 2; ++qt) {
          uint4 o;
          o.x = pack2(st[k2 * 2][qt][0], st[k2 * 2][qt][1]); o.y = pack2(st[k2 * 2][qt][2], st[k2 * 2][qt][3]);
          o.z = pack2(st[k2 * 2 + 1][qt][0], st[k2 * 2 + 1][qt][1]); o.w = pack2(st[k2 * 2 + 1][qt][2], st[k2 * 2 + 1][qt][3]);
          pf[qt] = __builtin_bit_cast(bf16x8, o);
        }
#pragma unroll
        for (int d = 0; d < 4; ++d) {
          const bf16_t* vp = vs_ + (d * 16 + qi) * 72 + k2 * 32 + quad * 4;
          uint2 lo = *(const uint2*)vp, hi = *(const uint2*)(vp + 16);
          uint4 vv; vv.x = lo.x; vv.y = lo.y; vv.z = hi.x; vv.w = hi.y;
          bf16x8 vf = __builtin_bit_cast(bf16x8, vv);
          oacc[d][0] = __builtin_amdgcn_mfma_f32_16x16x32_bf16(vf, pf[0], oacc[d][0], 0, 0, 0);
          oacc[d][1] = __builtin_amdgcn_mfma_f32_16x16x32_bf16(vf, pf[1], oacc[d][1], 0, 0, 0);
        }
      }
    }
    if (kt + 1 < nkt) ASTORE(cur ^ 1);
    __syncthreads();
  }
#undef ALOAD
#undef ASTORE
#pragma unroll
  for (int qt = 0; qt < 2; ++qt) {
    float l = lrun[qt];
    l += __shfl_xor(l, 16);
    l += __shfl_xor(l, 32);
    const float inv = 1.f / l;
    const size_t m = (size_t)b * 4096 + q0 + qt * 16 + qi;
#pragma unroll
    for (int d = 0; d < 4; ++d) {
      uint2 o; o.x = pack2(oacc[d][qt][0] * inv, oacc[d][qt][1] * inv); o.y = pack2(oacc[d][qt][2] * inv, oacc[d][qt][3] * inv);
      *(uint2*)(ycat + m * 1024 + 640 + h * 64 + d * 16 + quad * 4) = o;
    }
  }
}

DI void post_phase(const Params& P, int l) {
  const float* yraw = (const float*)(P.ws + OFF_YRAW);
  const bf16_t* SI = (const bf16_t*)(P.ws + OFF_SI);
  const float* bonus = (const float*)(P.ws + OFF_BONUS);
  bf16_t* ycat = (bf16_t*)(P.ws + OFF_H);
  const int lane = threadIdx.x & 63, w = threadIdx.x >> 6;
  float lnw[6], lnb[6];
#pragma unroll
  for (int h = 0; h < 6; ++h) { lnw[h] = P.rln_w[l * 384 + h * 64 + lane]; lnb[h] = P.rln_b[l * 384 + h * 64 + lane]; }
  for (int m = blockIdx.x * 4 + w; m < 16384; m += gridDim.x * 4) {
    const int b = m >> 12, t = m & 4095;
    float y[6], v[6], g[6], bo[6];
#pragma unroll
    for (int h = 0; h < 6; ++h) {
      y[h] = yraw[(size_t)m * 1168 + h * 64 + lane];
      v[h] = bf2f(SI[((size_t)(b * 6 + h) * 4096 + t) * 384 + 320 + lane]);
      g[h] = bf2f(ycat[(size_t)m * 1024 + h * 64 + lane]);
      bo[h] = bonus[(size_t)m * 6 + h];
    }
#pragma unroll
    for (int h = 0; h < 6; ++h) {
      float mean = wave_sum(y[h]) * (1.f / 64.f);
      float d = y[h] - mean;
      float var = wave_sum(d * d) * (1.f / 64.f);
      float yn = d * rsqrtf(var + 64e-5f) * lnw[h] + lnb[h];
      float o = (yn + bo[h] * v[h]) * g[h];
      ycat[(size_t)m * 1024 + h * 64 + lane] = f2bfh(o);
    }
  }
}

template <int PH>
DI void run_phase(const Params& P, char* smem, int* s_item, const XcdBarrier& xb) {
  char* ws = P.ws;
  float* mod = (float*)(ws + OFF_MOD);
  int* cnt = (int*)(ws + OFF_CNT);
  bf16_t* Hb = (bf16_t*)(ws + OFF_H);
  if (PH == 0) {
    if (blockIdx.x == 0 && threadIdx.x < 64) cnt[threadIdx.x] = 0;
    mod_items(P, smem);
    convert_layer(P, 0, smem);
    return;
  }
  if (PH == NPHASE - 1) {
    const float* m1 = mod + (size_t)(1 * 4) * 6144;
    row_pass(P.out, (const bf16_t*)(ws + OFF_Y), m1 + 5 * 1024, P.g_post_ffn + 1024, P.out, nullptr, nullptr, nullptr, nullptr);
    return;
  }
  constexpr int l = (PH - 1) / 9, sub = (PH - 1) % 9;
  const float* ml = mod + (size_t)(l * 4) * 6144;
  if (sub == 0) {
    if (l == 0) {
      row_pass(P.x, nullptr, nullptr, nullptr, nullptr, P.g_pre_mix, ml + 1024, ml, Hb);
    } else {
      convert_layer(P, l, smem);
      const float* mp = mod + (size_t)((l - 1) * 4) * 6144;
      row_pass(P.out, (const bf16_t*)(ws + OFF_Y), mp + 5 * 1024, P.g_post_ffn + (l - 1) * 1024, P.out,
               P.g_pre_mix + l * 1024, ml + 1024, ml, Hb);
    }
  } else if (sub == 1) {
    for (int rep = 0; rep < 1 + ((PROBE_REP >> 0) & 1); ++rep)
    gemm_phase<EPI_P>(Hb, 1024, (const bf16_t*)(ws + OFF_WIN), 1024, 19, smem, ws + OFF_P, nullptr);
  } else if (sub == 2) {
    for (int i = blockIdx.x; i < 1536; i += gridDim.x) prep_rwkv_item(P, l, i, smem);
  } else if (sub == 3) {
    const int NS = 96, G = gridDim.x;
    unsigned* sub_ctr = (unsigned*)&cnt[8 + l];
    if (G >= 2 * NS) {
      if ((int)blockIdx.x < NS) {
        __builtin_amdgcn_s_setprio(3);
        scan_item(P, blockIdx.x, smem);
        __builtin_amdgcn_s_setprio(0);
        sub_barrier_wait(sub_ctr, (unsigned)(G - NS));
      } else {
        const int G2 = G - NS, b2 = blockIdx.x - NS;
        for (int i = b2; i < 768; i += G2)
          gemm_tile<EPI_KV>((const bf16_t*)(ws + OFF_P) + 2048, 2336, (const bf16_t*)(ws + OFF_WUKV), 256, (i / 6) * 128, (i % 6) * 128, smem, ws + OFF_KN, ws + OFF_VT);
        int bid = (b2 + G2 - (768 % G2)) % G2;
        for (int i = bid; i < 640; i += G2)
          gemm_tile<EPI_Q>((const bf16_t*)(ws + OFF_P) + 1792, 2336, (const bf16_t*)(ws + OFF_WUQ), 256, (i / 5) * 128, (i % 5) * 128, smem, ws + OFF_Q, nullptr);
        bid = (b2 + G2 - ((768 + 640) % G2)) % G2;
        for (int i = bid; i < 512; i += G2) prep_conv_item(P, l, i, smem);
        bid = (b2 + G2 - ((768 + 640 + 512) % G2)) % G2;
        for (int i = bid; i < 64; i += G2) prep_kpe_item(P, i);
        sub_barrier(sub_ctr, (unsigned)G2);
      }
    } else {
      for (int i = blockIdx.x; i < 768; i += G)
        gemm_tile<EPI_KV>((const bf16_t*)(ws + OFF_P) + 2048, 2336, (const bf16_t*)(ws + OFF_WUKV), 256, (i / 6) * 128, (i % 6) * 128, smem, ws + OFF_KN, ws + OFF_VT);
      for (int i = blockIdx.x; i < 640; i += G)
        gemm_tile<EPI_Q>((const bf16_t*)(ws + OFF_P) + 1792, 2336, (const bf16_t*)(ws + OFF_WUQ), 256, (i / 5) * 128, (i % 5) * 128, smem, ws + OFF_Q, nullptr);
      for (int i = blockIdx.x; i < 512; i += G) prep_conv_item(P, l, i, smem);
      for (int i = blockIdx.x; i < 64; i += G) prep_kpe_item(P, i);
      for (int it = blockIdx.x; it < NS; it += G) scan_item(P, it, smem);
      xcd_barrier(xb);
    }
    while (true) {
      __syncthreads();
      if (threadIdx.x == 0) *s_item = atomicAdd(&cnt[l], 1);
      __syncthreads();
      int item = *s_item;
      if (item >= 768) break;
      attn_item(P, item, smem);
    }
  } else if (sub == 4) {
    post_phase(P, l);
  } else if (sub == 5) {
    for (int rep = 0; rep < 1 + ((PROBE_REP >> 3) & 1); ++rep)
    gemm_phase<EPI_Y>(Hb, 1024, (const bf16_t*)(ws + OFF_WOUT), 1024, 8, smem, ws + OFF_Y, nullptr);
  } else if (sub == 6) {
    const float* xs = (l == 0) ? P.x : P.out;
    row_pass(xs, (const bf16_t*)(ws + OFF_Y), ml + 2 * 1024, P.g_post_mix + l * 1024, P.out,
             P.g_pre_ffn + l * 1024, ml + 4 * 1024, ml + 3 * 1024, Hb);
  } else if (sub == 7) {
    for (int rep = 0; rep < 1 + ((PROBE_REP >> 4) & 1); ++rep)
    gemm_phase<EPI_FF1>(Hb, 1024, (const bf16_t*)(ws + OFF_WFF1), 1024, 32, smem, ws + OFF_HID, nullptr);
  } else if (sub == 8) {
    for (int rep = 0; rep < 1 + ((PROBE_REP >> 5) & 1); ++rep)
    gemm_phase<EPI_Y>((const bf16_t*)(ws + OFF_HID), 4096, (const bf16_t*)(ws + OFF_WFF2), 4096, 8, smem, ws + OFF_Y, nullptr);
  }
}

__global__ void __launch_bounds__(256, 2) fwd_kernel(Params P, int ph_begin, int ph_end, int use_cg) {
  __shared__ __attribute__((aligned(16))) char smem[74752];
  __shared__ int s_item;
  __shared__ uint4 xb_words;
  cg::grid_group grid = cg::this_grid();
  if (threadIdx.x == 0) xb_words = make_uint4(0u, 0u, 0u, 0u);
  __syncthreads();
  XcdBarrier xb = xcd_barrier_post((unsigned*)(P.ws + OFF_BAR), (volatile LAS unsigned*)&xb_words);
#define RUN(k) if (ph_begin <= (k) && (k) < ph_end) { if ((k) > ph_begin) { if (use_cg) grid.sync(); else xcd_barrier(xb); } run_phase<(k)>(P, smem, &s_item, xb); }
  RUN(0) RUN(1) RUN(2) RUN(3) RUN(4) RUN(5) RUN(6) RUN(7) RUN(8) RUN(9)
  RUN(10) RUN(11) RUN(12) RUN(13) RUN(14) RUN(15) RUN(16) RUN(17) RUN(18) RUN(19)
#undef RUN
}

extern "C" void kernel_launch(void* const* d_in, const int* in_sizes, int n_in, void* d_out, int out_size, void* d_ws,
                              size_t ws_size, hipStream_t stream) {
  Params P{};
  P.x = (const float*)d_in[0]; P.c = (const float*)d_in[1]; P.pos = (const int*)d_in[2];
  P.g_pre_mix = (const float*)d_in[3]; P.g_post_mix = (const float*)d_in[4]; P.g_pre_ffn = (const float*)d_in[5];
  P.g_post_ffn = (const float*)d_in[6]; P.w_ada = (const float*)d_in[7]; P.b_ada = (const float*)d_in[8];
  P.w_in = (const float*)d_in[9]; P.w_out = (const float*)d_in[10];
  P.mu = (const float*)d_in[11]; P.w0 = (const float*)d_in[12]; P.w2 = (const float*)d_in[13]; P.a0 = (const float*)d_in[14];
  P.a2 = (const float*)d_in[15]; P.g2 = (const float*)d_in[16]; P.k_k = (const float*)d_in[17]; P.k_a = (const float*)d_in[18];
  P.r_k = (const float*)d_in[19]; P.rln_w = (const float*)d_in[20]; P.rln_b = (const float*)d_in[21];
  P.conv_w = (const float*)d_in[22]; P.conv_b = (const float*)d_in[23]; P.cln_w = (const float*)d_in[24]; P.cln_b = (const float*)d_in[25];
  P.q_norm = (const float*)d_in[26]; P.w_uq = (const float*)d_in[27]; P.kv_norm = (const float*)d_in[28]; P.w_ukv = (const float*)d_in[29];
  P.w_ff1 = (const float*)d_in[30]; P.w_ff2 = (const float*)d_in[31];
  P.out = (float*)d_out; P.ws = (char*)d_ws;
  static int grid_blocks = 0;
  if (!grid_blocks) {
    int dev = 0, cus = 0, per_cu = 0;
    hipGetDevice(&dev);
    hipDeviceGetAttribute(&cus, hipDeviceAttributeMultiprocessorCount, dev);
    hipOccupancyMaxActiveBlocksPerMultiprocessor(&per_cu, fwd_kernel, 256, 0);
    if (per_cu < 1) per_cu = 1;
    if (per_cu > 2) per_cu = 2;
    grid_blocks = cus * per_cu;
  }
#if SINGLE_LAUNCH
  int pb = 0, pe = NPHASE, ucg = 0;
  hipMemsetAsync((char*)d_ws + OFF_BAR, 0, XCD_BAR_WORDS * 4, stream);
  void* args[] = {&P, &pb, &pe, &ucg};
  hipError_t e = hipLaunchCooperativeKernel((void*)fwd_kernel, dim3(grid_blocks), dim3(256), args, 0, stream);
  if (e != hipSuccess) fprintf(stderr, "cooperative launch failed: %s (grid %d)\n", hipGetErrorString(e), grid_blocks);
#else
  for (int ph = 0; ph < NPHASE; ++ph) fwd_kernel<<<grid_blocks, 256, 0, stream>>>(P, ph, ph + 1, 0);
#endif
}
```
